# Optimizing an MI355X kernel written in HIP

```python
import jax, jax.numpy as jnp
from jax import lax
import numpy as np

D_MODEL = 4096
BATCH = 2
SEQ = 8192
DEPTH = 1

CHUNK = 64
Q_BLOCK = 128
SB_HEADS = 16
SB_HEAD_DIM = 128
SB_WIDTH = SB_HEADS * SB_HEAD_DIM
RET_HEADS = 8
RET_HEAD_DIM = 256
RET_WIDTH = RET_HEADS * RET_HEAD_DIM
MIX_WIDTH = SB_WIDTH + RET_WIDTH
IN_WIDTH = 3 * SB_WIDTH + 4 * RET_WIDTH
D_FF = 4 * D_MODEL
ROPE_BASE = 10000.0
EPS = 1e-6

kernel_name = "hymba_stickbreak_retention_block"


def rms_norm(x, g):
    xf = x.astype(jnp.float32)
    y = xf * lax.rsqrt(jnp.mean(xf * xf, axis=-1, keepdims=True) + EPS)
    return (y * g.astype(jnp.float32)).astype(x.dtype)


def to_heads(t, n_heads):
    b, s, w = t.shape
    return t.reshape(b, s, n_heads, w // n_heads).transpose(0, 2, 1, 3)


def from_heads(t):
    b, h, s, d = t.shape
    return t.transpose(0, 2, 1, 3).reshape(b, s, h * d)


def stick_breaking_attention(q, k, v):
    b, h, s, dh = q.shape
    scale = dh ** -0.5
    outs = []
    for start in range(0, s, Q_BLOCK):
        end = start + Q_BLOCK
        qb = q[:, :, start:end]
        kp = k[:, :, :end]
        vp = v[:, :, :end]
        z = jnp.einsum('bhqd,bhkd->bhqk', qb, kp).astype(jnp.float32) * scale
        t_pos = start + jnp.arange(Q_BLOCK)[:, None]
        s_pos = jnp.arange(end)[None, :]
        mask = s_pos < t_pos
        log_beta = jax.nn.log_sigmoid(z)
        log_one_minus = jnp.where(mask, log_beta - z, 0.0)
        tail = lax.cumsum(log_one_minus, axis=3, reverse=True) - log_one_minus
        a = jnp.where(mask, jnp.exp(log_beta + tail), 0.0)
        outs.append(jnp.einsum('bhqk,bhkd->bhqd', a.astype(vp.dtype), vp))
    return jnp.concatenate(outs, axis=2)


def rotary(x, pos):
    half = x.shape[-1] // 2
    inv_freq = ROPE_BASE ** (-jnp.arange(half, dtype=jnp.float32) / half)
    ang = pos.astype(jnp.float32)[:, None] * inv_freq[None, :]
    cos, sin = jnp.cos(ang), jnp.sin(ang)
    x1, x2 = x[..., :half], x[..., half:]
    return jnp.concatenate([x1 * cos - x2 * sin, x2 * cos + x1 * sin], axis=-1)


def retention_chunkwise(q, k, v):
    b, h, s, dk = q.shape
    dv = v.shape[-1]
    n = s // CHUNK
    log_gamma = jnp.log1p(-(2.0 ** (-5.0 - jnp.arange(h, dtype=jnp.float32))))
    idx = jnp.arange(CHUNK, dtype=jnp.float32)
    rel = idx[:, None] - idx[None, :]
    decay_mask = jnp.where(rel >= 0.0,
                           jnp.exp(log_gamma[:, None, None] * jnp.maximum(rel, 0.0)), 0.0)
    q_decay = jnp.exp(log_gamma[:, None] * (idx + 1.0))
    k_decay = jnp.exp(log_gamma[:, None] * (CHUNK - 1.0 - idx))
    chunk_decay = jnp.exp(log_gamma * CHUNK)

    qc = q.reshape(b, h, n, CHUNK, dk)
    kc = k.reshape(b, h, n, CHUNK, dk)
    vc = v.reshape(b, h, n, CHUNK, dv)
    scores = jnp.einsum('bhncd,bhnmd->bhncm', qc, kc) * decay_mask[None, :, None]
    inner = jnp.einsum('bhncm,bhnme->bhnce', scores, vc)

    def step(state, xs):
        q_i, k_i, v_i = xs
        cross = jnp.einsum('bhcd,bhde->bhce', q_i, state) * q_decay[None, :, :, None]
        state = state * chunk_decay[None, :, None, None] + jnp.einsum(
            'bhcd,bhce->bhde', k_i * k_decay[None, :, :, None], v_i)
        return state, cross

    xs = (jnp.moveaxis(qc, 2, 0), jnp.moveaxis(kc, 2, 0), jnp.moveaxis(vc, 2, 0))
    state0 = jnp.zeros((b, h, dk, dv), jnp.float32)
    _, cross = lax.scan(step, state0, xs)
    cross = jnp.moveaxis(cross, 0, 2)
    return (inner + cross).reshape(b, h, s, dv)


def head_group_norm(y, g):
    mu = jnp.mean(y, axis=-1, keepdims=True)
    yc = y - mu
    yn = yc * lax.rsqrt(jnp.mean(yc * yc, axis=-1, keepdims=True) + EPS)
    return from_heads(yn) * g.astype(jnp.float32)


def setup_inputs(seed: int = 0) -> dict:
    key = jax.random.key(seed)
    ks = jax.random.split(key, 10)
    f32 = jnp.float32

    def gain(k, n):
        return 1.0 + 0.02 * jax.random.normal(k, (DEPTH, n), f32)

    return {
        "x": jax.random.normal(ks[0], (BATCH, SEQ, D_MODEL), f32),
        "attn_norm_g": gain(ks[1], D_MODEL),
        "w_in": jax.random.normal(ks[2], (DEPTH, D_MODEL, IN_WIDTH), f32) * D_MODEL ** -0.5,
        "sb_norm_g": gain(ks[3], SB_WIDTH),
        "ret_norm_g": gain(ks[4], RET_WIDTH),
        "w_out": jax.random.normal(ks[5], (DEPTH, MIX_WIDTH, D_MODEL), f32) * MIX_WIDTH ** -0.5,
        "mlp_norm_g": gain(ks[6], D_MODEL),
        "w_up": jax.random.normal(ks[7], (DEPTH, D_MODEL, D_FF), f32) * D_MODEL ** -0.5,
        "w_down": jax.random.normal(ks[8], (DEPTH, D_FF, D_MODEL), f32) * D_FF ** -0.5,
        "final_norm_g": 1.0 + 0.02 * jax.random.normal(ks[9], (D_MODEL,), f32),
    }


def reference(x, attn_norm_g, w_in, sb_norm_g, ret_norm_g, w_out, mlp_norm_g, w_up, w_down,
              final_norm_g):
    s = x.shape[1]
    pos = jnp.arange(s, dtype=jnp.int32)
    for l in range(DEPTH):
        h = rms_norm(x, attn_norm_g[l])
        proj = h @ w_in[l]
        o = 0
        sb_q = proj[..., o:o + SB_WIDTH]; o += SB_WIDTH
        sb_k = proj[..., o:o + SB_WIDTH]; o += SB_WIDTH
        sb_v = proj[..., o:o + SB_WIDTH]; o += SB_WIDTH
        r_q = proj[..., o:o + RET_WIDTH]; o += RET_WIDTH
        r_k = proj[..., o:o + RET_WIDTH]; o += RET_WIDTH
        r_v = proj[..., o:o + RET_WIDTH]; o += RET_WIDTH
        r_g = proj[..., o:o + RET_WIDTH]

        sb = stick_breaking_attention(to_heads(sb_q, SB_HEADS), to_heads(sb_k, SB_HEADS),
                                      to_heads(sb_v, SB_HEADS))
        sb = rms_norm(from_heads(sb), sb_norm_g[l])

        rq = rotary(to_heads(r_q, RET_HEADS).astype(jnp.float32), pos)
        rk = rotary(to_heads(r_k, RET_HEADS).astype(jnp.float32), pos) * RET_HEAD_DIM ** -0.5
        rv = to_heads(r_v, RET_HEADS).astype(jnp.float32)
        ret = head_group_norm(retention_chunkwise(rq, rk, rv), ret_norm_g[l])
        ret = (jax.nn.silu(r_g.astype(jnp.float32)) * ret).astype(x.dtype)

        mixed = jnp.concatenate([sb.astype(x.dtype), ret], axis=-1)
        x = x + mixed @ w_out[l]

        h2 = rms_norm(x, mlp_norm_g[l])
        x = x + jnp.square(jax.nn.relu(h2 @ w_up[l])) @ w_down[l]
    return rms_norm(x, final_norm_g)
```

```cpp
#include <hip/hip_runtime.h>
#include <cstdio>
#include <cstdint>

namespace pg8 {
#define PG8_LAS __attribute__((address_space(3)))
typedef unsigned short bf16_t;
typedef short bf16x8 __attribute__((ext_vector_type(8)));
typedef float f32x4 __attribute__((ext_vector_type(4)));
typedef unsigned u32x4 __attribute__((ext_vector_type(4)));
constexpr int BM = 256, BK = 64, HALF = 128, HTB = HALF * BK * 2, STAGE_BYTES = 8 * HTB, NXCD = 8, WGM = 8;

__host__ __device__ __forceinline__ int lds_byte(int r, int c) { const int st = (r >> 4) * 2 + (c >> 5), rr = r & 15, cc = c & 31, ob = rr * 64 + cc * 2; return st * 1024 + (ob ^ (((ob >> 9) & 1) << 5)); }
__host__ __device__ __forceinline__ void stage_rc(int b, int& R, int& C) { const int st = b / 1024, sb = b % 1024, swz = sb ^ (((sb >> 9) & 1) << 5); R = (st >> 1) * 16 + swz / 64; C = (st & 1) * 32 + (swz % 64) / 2; }
__host__ __device__ __forceinline__ int perm32(int rho) { const int n = rho >> 4, i = rho & 15; return 8 * (i >> 2) + 4 * n + (i & 3); }

struct Unit { int pm, pn; };
struct Gemm { const bf16_t* A; const bf16_t* Bt; int M, N, K; };

struct StaticOrder {
    int nM, nN, nwg, G, c;
    __host__ __device__ void init(int M, int N, int G_, int c_) { nM = M / BM; nN = N / BM; nwg = nM * nN; G = G_; c = c_; }
    __host__ __device__ bool next(int i, Unit& u) const {
        const long L = (long)i * G + c; if (L >= nwg) return false;
        int wgid = (int)L; { const int q = nwg / NXCD, r = nwg % NXCD, xcd = wgid % NXCD, off = wgid / NXCD; wgid = (xcd < r ? xcd * (q + 1) : r * (q + 1) + (xcd - r) * q) + off; }
        const int nig = WGM * nN, gid = wgid / nig, fm = gid * WGM, gsz = (nM - fm) < WGM ? (nM - fm) : WGM;
        u.pm = fm + ((wgid % nig) % gsz); u.pn = (wgid % nig) / gsz; return true;
    }
    __device__ __forceinline__ void a_ready(const Unit&) const {}
    __device__ __forceinline__ void done(const Unit&) const {}
};

__device__ __forceinline__ unsigned cvt_pk_bf16(float lo, float hi) { unsigned r; asm volatile("v_cvt_pk_bf16_f32 %0, %1, %2" : "=v"(r) : "v"(lo), "v"(hi)); return r; }

template <class Epi, class Sched, bool ALIGN_EPI = false, bool SP2 = false>
__device__ __forceinline__ void gemm_phase(PG8_LAS unsigned char* lds, const Gemm g, const Sched& S, const Epi& E) {
    const int tid = threadIdx.x, wid = __builtin_amdgcn_readfirstlane(tid >> 6), lane = tid & 63, wr = wid >> 2, wc = wid & 3, fr = lane & 15, fq = lane >> 4;
    const int K = g.K, nt = K / BK;
    unsigned voffA[2], voffB[2];
#pragma unroll
    for (int i = 0; i < 2; ++i) { int R, C; stage_rc(tid * 16 + i * 8192, R, C); const int Rb = Epi::PERM ? ((R & ~31) + perm32(R & 31)) : R;
        voffA[i] = (unsigned)(R * K + C) * 2u; voffB[i] = (unsigned)(Rb * K + C) * 2u; }
    const size_t kstep = (size_t)(BK * 2);
    const size_t hstep = (size_t)HALF * K * 2;
    const size_t tstep = 2 * hstep;
    const unsigned ldsw = (unsigned)wid * 1024u;
    const int aoff = lds_byte(wr * 64 + fr, fq * 8), boff = lds_byte(wc * 32 + fr, fq * 8);
#define PG8_SA(b, h) (((b) * 2 + (h)) * HTB)
#define PG8_SB(b, h) ((4 + (b) * 2 + (h)) * HTB)
#define PG8_STAGE(bufoff, gbase, voff) do { _Pragma("unroll") for (int _i = 0; _i < 2; ++_i) \
        __builtin_amdgcn_global_load_lds((const unsigned*)((const char*)(gbase) + (voff)[_i]), (PG8_LAS unsigned*)(lds + (bufoff) + ldsw + _i * 8192), 16, 0, 0); } while (0)
#define PG8_LDA(dst, b, h) do { _Pragma("unroll") for (int m = 0; m < 4; ++m) _Pragma("unroll") for (int k = 0; k < 2; ++k) dst[m][k] = *(const PG8_LAS bf16x8*)(lds + PG8_SA(b, h) + aoff + m * 2048 + k * 1024); } while (0)
#define PG8_LDB(dst, b, h) do { _Pragma("unroll") for (int n = 0; n < 2; ++n) _Pragma("unroll") for (int k = 0; k < 2; ++k) dst[n][k] = *(const PG8_LAS bf16x8*)(lds + PG8_SB(b, h) + boff + n * 2048 + k * 1024); } while (0)
#define PG8_MMA(ai, bj, At, Bt) do { __builtin_amdgcn_s_setprio(1); _Pragma("unroll") for (int m = 0; m < 4; ++m) _Pragma("unroll") for (int n = 0; n < 2; ++n) _Pragma("unroll") for (int k = 0; k < 2; ++k) \
        acc[ai][bj][m][n] = __builtin_amdgcn_mfma_f32_16x16x32_bf16(Bt[n][k], At[m][k], acc[ai][bj][m][n], 0, 0, 0); __builtin_amdgcn_s_setprio(0); } while (0)
#define PG8_WAIT_V(n) asm volatile("s_waitcnt vmcnt(" #n ")" ::: "memory")
#define PG8_WAIT_L(n) asm volatile("s_waitcnt lgkmcnt(" #n ")" ::: "memory")
#define PG8_BAR __builtin_amdgcn_s_barrier()
#define PG8_SCHED __builtin_amdgcn_sched_barrier(0)
    Unit cur, nxt; int ui = 0;
    if (!S.next(0, cur)) return;
    f32x4 acc[2][2][4][2];
#pragma unroll
    for (int a = 0; a < 2; ++a)
#pragma unroll
        for (int b = 0; b < 2; ++b)
#pragma unroll
            for (int m = 0; m < 4; ++m)
#pragma unroll
                for (int n = 0; n < 2; ++n) acc[a][b][m][n] = (f32x4){0.f, 0.f, 0.f, 0.f};
    bf16x8 At[4][2], B0[2][2], B1[2][2];
    const char* cA = (const char*)g.A + (size_t)cur.pm * tstep; const char* cB = (const char*)g.Bt + (size_t)cur.pn * tstep;
    S.a_ready(cur);
    if constexpr (SP2) {
        PG8_STAGE(PG8_SB(0, 0), cB, voffB); PG8_STAGE(PG8_SB(0, 1), cB + hstep, voffB); PG8_STAGE(PG8_SA(0, 0), cA, voffA); PG8_STAGE(PG8_SA(0, 1), cA + hstep, voffA);
        if (wr == 1) PG8_BAR;
        PG8_WAIT_V(2); PG8_BAR;
        PG8_STAGE(PG8_SB(1, 0), cB + kstep, voffB); PG8_STAGE(PG8_SA(1, 0), cA + kstep, voffA); PG8_STAGE(PG8_SB(1, 1), cB + hstep + kstep, voffB);
        PG8_WAIT_V(6); PG8_BAR;
    } else {
        PG8_STAGE(PG8_SB(0, 0), cB, voffB); PG8_STAGE(PG8_SA(0, 0), cA, voffA); PG8_STAGE(PG8_SB(0, 1), cB + hstep, voffB); PG8_STAGE(PG8_SA(0, 1), cA + hstep, voffA);
        if (wr == 1) PG8_BAR;
        PG8_WAIT_V(4); PG8_BAR;
        PG8_STAGE(PG8_SB(1, 0), cB + kstep, voffB); PG8_STAGE(PG8_SA(1, 0), cA + kstep, voffA); PG8_STAGE(PG8_SB(1, 1), cB + hstep + kstep, voffB);
        PG8_WAIT_V(6); PG8_BAR;
    }
    for (;;) {
        const bool has_next = S.next(ui + 1, nxt);
        const char* nA = has_next ? (const char*)g.A + (size_t)nxt.pm * tstep : cA; const char* nB = has_next ? (const char*)g.Bt + (size_t)nxt.pn * tstep : cB;
        for (int t = 0; t < nt; t += 2) {
            const bool last = (t == nt - 2);
            const char* a1 = cA + (size_t)(t + 1) * kstep;
            const char* a2 = last ? nA : cA + (size_t)(t + 2) * kstep; const char* b2 = last ? nB : cB + (size_t)(t + 2) * kstep;
            const char* a3 = a2 + kstep; const char* b3 = b2 + kstep;
            if (last && has_next) S.a_ready(nxt);
            if constexpr (SP2) {
            PG8_LDB(B0, 0, 0); PG8_LDB(B1, 0, 1); PG8_SCHED; PG8_LDA(At, 0, 0); PG8_STAGE(PG8_SA(1, 1), a1 + hstep, voffA);
            PG8_WAIT_V(8); PG8_WAIT_L(0); PG8_BAR; PG8_MMA(0, 0, At, B0); PG8_MMA(0, 1, At, B1); PG8_BAR; PG8_SCHED;
            PG8_LDA(At, 0, 1); PG8_STAGE(PG8_SB(0, 0), b2, voffB); PG8_STAGE(PG8_SB(0, 1), b2 + hstep, voffB); PG8_STAGE(PG8_SA(0, 0), a2, voffA);
            PG8_WAIT_V(8); PG8_WAIT_L(0); PG8_BAR; PG8_MMA(1, 0, At, B0); PG8_MMA(1, 1, At, B1); PG8_BAR; PG8_SCHED;
            PG8_LDB(B0, 1, 0); PG8_LDB(B1, 1, 1); PG8_SCHED; PG8_LDA(At, 1, 0); PG8_STAGE(PG8_SA(0, 1), a2 + hstep, voffA);
            PG8_WAIT_V(8); PG8_WAIT_L(0); PG8_BAR; PG8_MMA(0, 0, At, B0); PG8_MMA(0, 1, At, B1); PG8_BAR; PG8_SCHED;
            PG8_LDA(At, 1, 1); PG8_STAGE(PG8_SB(1, 0), b3, voffB); PG8_STAGE(PG8_SB(1, 1), b3 + hstep, voffB); PG8_STAGE(PG8_SA(1, 0), a3, voffA);
            PG8_WAIT_V(8); PG8_WAIT_L(0); PG8_BAR; PG8_MMA(1, 0, At, B0); PG8_MMA(1, 1, At, B1); PG8_BAR; PG8_SCHED;
            } else {
            PG8_LDB(B0, 0, 0); PG8_SCHED; PG8_LDA(At, 0, 0); PG8_STAGE(PG8_SA(1, 1), a1 + hstep, voffA);
            PG8_WAIT_L(8); PG8_BAR; PG8_WAIT_L(0); PG8_MMA(0, 0, At, B0); PG8_BAR; PG8_SCHED;
            PG8_LDB(B1, 0, 1); PG8_STAGE(PG8_SB(0, 0), b2, voffB);
            PG8_BAR; PG8_WAIT_L(0); PG8_MMA(0, 1, At, B1); PG8_BAR;
            PG8_LDA(At, 0, 1); PG8_STAGE(PG8_SA(0, 0), a2, voffA);
            PG8_BAR; PG8_WAIT_L(0); PG8_MMA(1, 0, At, B0); PG8_BAR; PG8_SCHED;
            PG8_STAGE(PG8_SB(0, 1), b2 + hstep, voffB);
            PG8_WAIT_V(6); PG8_BAR; PG8_MMA(1, 1, At, B1); PG8_BAR;
            PG8_LDB(B0, 1, 0); PG8_SCHED; PG8_LDA(At, 1, 0); PG8_STAGE(PG8_SA(0, 1), a2 + hstep, voffA);
            PG8_WAIT_L(8); PG8_BAR; PG8_WAIT_L(0); PG8_MMA(0, 0, At, B0); PG8_BAR; PG8_SCHED;
            PG8_LDB(B1, 1, 1); PG8_STAGE(PG8_SB(1, 0), b3, voffB);
            PG8_BAR; PG8_WAIT_L(0); PG8_MMA(0, 1, At, B1); PG8_BAR;
            PG8_LDA(At, 1, 1); PG8_STAGE(PG8_SA(1, 0), a3, voffA);
            PG8_BAR; PG8_WAIT_L(0); PG8_MMA(1, 0, At, B0); PG8_BAR; PG8_SCHED;
            PG8_STAGE(PG8_SB(1, 1), b3 + hstep, voffB);
            PG8_WAIT_V(6); PG8_BAR; PG8_MMA(1, 1, At, B1); PG8_BAR;
            }
        }
        if constexpr (ALIGN_EPI) { if (wr == 0) PG8_BAR; }
        E(acc, cur, wr, wc, fr, fq); S.done(cur);
        if (!has_next) break;
#pragma unroll
        for (int a = 0; a < 2; ++a)
#pragma unroll
            for (int b = 0; b < 2; ++b)
#pragma unroll
                for (int m = 0; m < 4; ++m)
#pragma unroll
                    for (int n = 0; n < 2; ++n) acc[a][b][m][n] = (f32x4){0.f, 0.f, 0.f, 0.f};
        cur = nxt; cA = nA; cB = nB; ++ui;
        if constexpr (ALIGN_EPI) { if (wr == 1) PG8_BAR; }
    }
    PG8_WAIT_V(0);
    if constexpr (!ALIGN_EPI) { if (wr == 0) PG8_BAR; }
    PG8_BAR;
#undef PG8_SA
#undef PG8_SB
#undef PG8_STAGE
#undef PG8_LDA
#undef PG8_LDB
#undef PG8_MMA
#undef PG8_WAIT_V
#undef PG8_WAIT_L
#undef PG8_BAR
#undef PG8_SCHED
}
}

constexpr int NWAVES = 8;
#ifndef MK_N_LAUNCHES
#define MK_N_LAUNCHES 1
#endif
constexpr int PER_PHASE = 11;
constexpr int N_LAUNCHES = MK_N_LAUNCHES;

constexpr int BATCH = 2, T = 8192, D = 4096, M = BATCH * T;
constexpr int SBH = 16, SBD = 128, RH = 8, RD = 256;
constexpr int NIN = 14336, FF = 16384;
constexpr int C_SBQ = 0, C_SBK = 2048, C_SBV = 4096, C_RQ = 6144, C_RK = 8192, C_RV = 10240, C_RG = 12288;
constexpr float EPS = 1e-6f;
constexpr float QSCALE = 0.12751743082459868f;

constexpr size_t MiB = 1u << 20;
constexpr size_t WS_CTL = 0, CTL_ZERO_BYTES = 1 * MiB;
constexpr size_t WS_XN = 1 * MiB;
constexpr size_t WS_WIN = 129 * MiB;
constexpr size_t WS_WOUT = 241 * MiB;
constexpr size_t WS_PROJ = 273 * MiB;
constexpr size_t WS_MIX = 721 * MiB;
constexpr size_t WS_ROPE = 849 * MiB;
constexpr size_t WS_STATE = 857 * MiB;
constexpr size_t WS_WUP = 129 * MiB;
constexpr size_t WS_HID = 273 * MiB;
constexpr size_t WS_WDOWN = 785 * MiB;
constexpr size_t WS_END = 921 * MiB;
constexpr int CW_TMO = 0, CW_CODE = 1, CW_BAR = 4096;

constexpr int RING_OFF = 0, RING_BYTES = 131072;
constexpr int LDSCTL_OFF = RING_BYTES, MISC_OFF = LDSCTL_OFF + 320;
constexpr int LDS_BYTES = 147456;

#define GAS __attribute__((address_space(1)))
#define LAS __attribute__((address_space(3)))
typedef unsigned short bf16;
typedef unsigned v4u __attribute__((ext_vector_type(4)));
typedef unsigned v2u __attribute__((ext_vector_type(2)));
typedef float f32x4 __attribute__((ext_vector_type(4)));
typedef GAS unsigned gu32;
#define RLX_AGENT __ATOMIC_RELAXED, __HIP_MEMORY_SCOPE_AGENT
#define LDS_WAIT() asm volatile("s_waitcnt lgkmcnt(0)" ::: "memory")
#define VM_WAIT() asm volatile("s_waitcnt vmcnt(0)" ::: "memory")
__device__ __forceinline__ unsigned f2bf(float f) { unsigned u = __builtin_bit_cast(unsigned, f); return (u + 0x7fffu + ((u >> 16) & 1u)) >> 16; }
__device__ __forceinline__ unsigned pk2(float lo, float hi) { return f2bf(lo) | (f2bf(hi) << 16); }
__device__ __forceinline__ float bf_lo(unsigned w) { return __builtin_bit_cast(float, w << 16); }
__device__ __forceinline__ float bf_hi(unsigned w) { return __builtin_bit_cast(float, w & 0xffff0000u); }

#define XB_TMO      128
#define XB_XCNT(j)  (256  + 64 * (j))
#define XB_XSUB(j)  (1280 + 64 * (j))
#define XB_XGEN(j)  (2304 + 64 * (j))
#define XB_TOP      3328
#define XB_TOPGEN   3392
#define XCD_BAR_WORDS 3456
#define XB_SPIN_CAP (1u << 18)

__device__ __forceinline__ unsigned xb_ld(unsigned* p)              { return __hip_atomic_load(p, __ATOMIC_RELAXED, __HIP_MEMORY_SCOPE_AGENT); }
__device__ __forceinline__ unsigned xb_add(unsigned* p, unsigned v) { return __hip_atomic_fetch_add(p, v, __ATOMIC_RELAXED, __HIP_MEMORY_SCOPE_AGENT); }
__device__ __forceinline__ unsigned xb_xcc_id() { return (unsigned)__builtin_amdgcn_s_getreg((3 << 11) | 20) & 0xFu; }
#define XB_SPIN(cond, bar) do { unsigned _sp = 0; while (cond) { __builtin_amdgcn_s_sleep(1); \
    if ((++_sp & 255u) == 0u) { if (xb_ld(&(bar)[XB_TMO])) break; if (_sp > XB_SPIN_CAP) { atomicAdd(&(bar)[XB_TMO], 1u); break; } } } } while (0)

struct XcdBarrier {
    unsigned* bar; unsigned x;
    volatile LAS unsigned* st;
};
__device__ __forceinline__ XcdBarrier xcd_barrier_post(unsigned* bar, volatile LAS unsigned* st) {
    XcdBarrier b; b.bar = bar; b.x = xb_xcc_id(); b.st = st;
    if (threadIdx.x == 0) (void)xb_add(&bar[XB_XCNT(b.x)], 1u);
    return b;
}
__device__ __forceinline__ void xcd_barrier_complete(unsigned* bar, unsigned x, unsigned& nloc, unsigned& nx) {
    const unsigned G = gridDim.x * gridDim.y * gridDim.z;
    unsigned sum, cnt, mine, sp = 0u;
    for (;;) {
        sum = 0u; cnt = 0u; mine = 0u;
#pragma unroll
        for (unsigned j = 0; j < 16; ++j) { const unsigned c = xb_ld(&bar[XB_XCNT(j)]); sum += c; cnt += (c > 0u) ? 1u : 0u; mine = (j == x) ? c : mine; }
        if (sum == G) break;
        __builtin_amdgcn_s_sleep(1);
        if ((++sp & 255u) == 0u) { if (xb_ld(&bar[XB_TMO])) break; if (sp > XB_SPIN_CAP) { atomicAdd(&bar[XB_TMO], 1u); break; } }
    }
    nloc = mine > 0u ? mine : 1u; nx = cnt > 0u ? cnt : 1u;
}
__device__ __forceinline__ void xcd_barrier(const XcdBarrier& b) {
    asm volatile("s_waitcnt vmcnt(0)" ::: "memory");
    __syncthreads();
    if (threadIdx.x == 0) {
        unsigned* bar = b.bar;
        __builtin_amdgcn_s_waitcnt(0);
        unsigned nloc = b.st[0], nx = b.st[1];
        if (nloc == 0u) { xcd_barrier_complete(bar, b.x, nloc, nx); b.st[0] = nloc; b.st[1] = nx; }
        const unsigned old = xb_add(&bar[XB_XSUB(b.x)], 1u);
        const unsigned gen = old / nloc;
        if (old + 1u == (gen + 1u) * nloc) {
            __builtin_amdgcn_fence(__ATOMIC_RELEASE, "agent");
            asm volatile("s_waitcnt vmcnt(0)" ::: "memory");
            const unsigned og = xb_add(&bar[XB_TOP], 1u);
            const unsigned tg = og / nx;
            if (og + 1u == (tg + 1u) * nx) xb_add(&bar[XB_TOPGEN], 1u);
            else XB_SPIN(xb_ld(&bar[XB_TOPGEN]) == tg, bar);
            __builtin_amdgcn_fence(__ATOMIC_ACQUIRE, "agent");
            xb_add(&bar[XB_XGEN(b.x)], 1u);
            asm volatile("s_waitcnt vmcnt(0)" ::: "memory");
        } else {
            XB_SPIN(xb_ld(&bar[XB_XGEN(b.x)]) == gen, bar);
            __builtin_amdgcn_fence(__ATOMIC_ACQUIRE, "agent");
            asm volatile("s_waitcnt vmcnt(0)" ::: "memory");
        }
    }
    __syncthreads();
}

struct Frame {
    LAS unsigned char* lds;
    volatile LAS unsigned* MISC;
    gu32* ctl;
    int tid, lane, wave;
    int vcu, G;
    const float* x; float* out;
    const float *g_attn, *w_in, *g_sb, *g_ret, *w_out, *g_mlp, *w_up, *w_down, *g_fin;
    bf16 *XN, *WIN, *WOUT, *PROJ, *MIX, *WUP, *HID, *WDOWN;
    float *SBO, *ROPE;
};

__device__ __forceinline__ float wave_sum(float v) {
#pragma unroll
    for (int o = 1; o < 64; o <<= 1) v += __shfl_xor(v, o);
    return v;
}
__device__ __forceinline__ void p0_transpose_item(const float* W, int K, int N, bf16* WT, LAS float* scr, int item, int lane) {
    const int nblk = N / 32, kb = item / nblk, nb = item % nblk, k0 = 64 * kb, n0 = 32 * nb;
#pragma unroll 8
    for (int i = 0; i < 32; ++i) { const int kk = 2 * i + (lane >> 5); scr[kk * 33 + (lane & 31)] = W[(size_t)(k0 + kk) * N + n0 + (lane & 31)]; }
    LDS_WAIT(); asm volatile("" ::: "memory");
    const int c = lane & 7;
#pragma unroll
    for (int j = 0; j < 4; ++j) { const int n = (lane >> 3) + 8 * j; const LAS float* s = scr + (8 * c) * 33 + n;
        v4u o; o.x = pk2(s[0 * 33], s[1 * 33]); o.y = pk2(s[2 * 33], s[3 * 33]); o.z = pk2(s[4 * 33], s[5 * 33]); o.w = pk2(s[6 * 33], s[7 * 33]);
        *(GAS v4u*)(WT + (size_t)(n0 + n) * K + k0 + 8 * c) = o; }
    LDS_WAIT(); asm volatile("" ::: "memory");
}
__device__ __forceinline__ void transpose_matrix(Frame& F, const float* W, int K, int N, bf16* WT) {
    LAS float* scr = (LAS float*)(F.lds + RING_OFF + F.wave * 16384);
    const int gw = F.vcu * NWAVES + F.wave, NGW = F.G * NWAVES;
    const int nitems = (K / 64) * (N / 32);
    for (int it = gw; it < nitems; it += NGW) p0_transpose_item(W, K, N, WT, scr, it, F.lane);
}
template <int NJ, bool OUT_BF16>
__device__ __forceinline__ void rms_row(const float* xrow, const float* g, void* orow, int lane) {
    const GAS f32x4* xr = (const GAS f32x4*)xrow + lane;
    f32x4 v[NJ]; float s = 0.f;
#pragma unroll
    for (int j = 0; j < NJ; ++j) { v[j] = xr[64 * j]; s += (v[j].x * v[j].x + v[j].y * v[j].y) + (v[j].z * v[j].z + v[j].w * v[j].w); }
    const float rstd = 1.0f / sqrtf(wave_sum(s) * (1.f / (256.f * NJ)) + EPS);
    const GAS f32x4* gr = (const GAS f32x4*)g + lane;
#pragma unroll
    for (int j = 0; j < NJ; ++j) { const f32x4 gg = gr[64 * j]; const f32x4 y = v[j] * rstd * gg;
        if constexpr (OUT_BF16) { v2u o; o.x = pk2(y.x, y.y); o.y = pk2(y.z, y.w); ((GAS v2u*)orow)[lane + 64 * j] = o; }
        else ((GAS f32x4*)orow)[lane + 64 * j] = y; }
}

__constant__ float c_log2g[8] = { -0.04580368961312479f, -0.02272007650008353f, -0.011315313227834146f, -0.005646563141142063f,
                                  -0.0028205190623786626f, -0.0014095702546713536f, -0.0007046129765893727f, -0.0003522634716290214f };
struct EpiProj {
    static constexpr bool PERM = true, AFTER_DRAIN = false;
    bf16* O; const float* rope;
    __device__ __forceinline__ void operator()(const pg8::f32x4 (&acc)[2][2][4][2], const pg8::Unit& u, int wr, int wc, int fr, int fq) const {
        const int kind = u.pn >> 3;
        const int row0 = u.pm * 256 + wr * 64 + fr, col0 = u.pn * 256 + wc * 32 + 8 * fq;
        if (kind == 3 || kind == 4) {
            const float L = c_log2g[u.pn & 7] * (kind == 3 ? 1.f : -1.f), mul = (kind == 3) ? 1.f : 0.0625f;
            const int i0 = wc * 32 + 8 * fq;
#pragma unroll
            for (int ai = 0; ai < 2; ++ai)
#pragma unroll
                for (int m = 0; m < 4; ++m) {
                    const int row = row0 + ai * 128 + m * 16, pos = row & (T - 1), tl = row & 255;
                    const float sc = __builtin_amdgcn_exp2f((float)(tl + 1) * L) * mul;
                    const float* cp = rope + (size_t)pos * 128 + i0; const float* sp = cp + (size_t)T * 128;
                    const f32x4 c0 = *(const f32x4*)cp, c1 = *(const f32x4*)(cp + 4), s0 = *(const f32x4*)sp, s1 = *(const f32x4*)(sp + 4);
                    const f32x4 a0 = acc[ai][0][m][0], a1 = acc[ai][0][m][1], b0 = acc[ai][1][m][0], b1 = acc[ai][1][m][1];
                    const f32x4 y0 = (a0 * c0 - b0 * s0) * sc, y1 = (a1 * c1 - b1 * s1) * sc, z0 = (b0 * c0 + a0 * s0) * sc, z1 = (b1 * c1 + a1 * s1) * sc;
                    bf16* rowp = O + (size_t)row * NIN + col0;
                    v4u w; w.x = pg8::cvt_pk_bf16(y0[0], y0[1]); w.y = pg8::cvt_pk_bf16(y0[2], y0[3]); w.z = pg8::cvt_pk_bf16(y1[0], y1[1]); w.w = pg8::cvt_pk_bf16(y1[2], y1[3]);
                    *(v4u*)rowp = w;
                    v4u w2; w2.x = pg8::cvt_pk_bf16(z0[0], z0[1]); w2.y = pg8::cvt_pk_bf16(z0[2], z0[3]); w2.z = pg8::cvt_pk_bf16(z1[0], z1[1]); w2.w = pg8::cvt_pk_bf16(z1[2], z1[3]);
                    *(v4u*)(rowp + 128) = w2;
                }
        } else {
            const float sc = (kind == 0) ? QSCALE : 1.f;
#pragma unroll
            for (int ai = 0; ai < 2; ++ai)
#pragma unroll
                for (int m = 0; m < 4; ++m) { bf16* rowp = O + (size_t)(row0 + ai * 128 + m * 16) * NIN + col0;
#pragma unroll
                    for (int bj = 0; bj < 2; ++bj) { f32x4 v0 = acc[ai][bj][m][0] * sc, v1 = acc[ai][bj][m][1] * sc;
                        if (kind == 6) {
#pragma unroll
                            for (int j = 0; j < 4; ++j) { v0[j] = v0[j] * __builtin_amdgcn_rcpf(1.f + __builtin_amdgcn_exp2f(-1.4426950408889634f * v0[j]));
                                                          v1[j] = v1[j] * __builtin_amdgcn_rcpf(1.f + __builtin_amdgcn_exp2f(-1.4426950408889634f * v1[j])); } }
                        v4u w; w.x = pg8::cvt_pk_bf16(v0[0], v0[1]); w.y = pg8::cvt_pk_bf16(v0[2], v0[3]); w.z = pg8::cvt_pk_bf16(v1[0], v1[1]); w.w = pg8::cvt_pk_bf16(v1[2], v1[3]);
                        *(v4u*)(rowp + bj * 128) = w; } }
        }
    }
};
struct EpiResF32 {
    static constexpr bool PERM = false, AFTER_DRAIN = false;
    const float* base; float* out; int ldc;
    __device__ __forceinline__ void operator()(const pg8::f32x4 (&acc)[2][2][4][2], const pg8::Unit& u, int wr, int wc, int fr, int fq) const {
        const int row0 = u.pm * 256 + wr * 64 + fr, col0 = u.pn * 256 + wc * 32 + 4 * fq;
#pragma unroll
        for (int ai = 0; ai < 2; ++ai)
#pragma unroll
            for (int m = 0; m < 4; ++m) { const size_t off = (size_t)(row0 + ai * 128 + m * 16) * ldc + col0;
#pragma unroll
                for (int bj = 0; bj < 2; ++bj)
#pragma unroll
                    for (int n = 0; n < 2; ++n) { const f32x4 b = *(const f32x4*)(base + off + bj * 128 + n * 16); *(f32x4*)(out + off + bj * 128 + n * 16) = b + acc[ai][bj][m][n]; } }
    }
};
struct EpiRelu2 {
    static constexpr bool PERM = true, AFTER_DRAIN = false;
    bf16* O; int ldc;
    __device__ __forceinline__ void operator()(const pg8::f32x4 (&acc)[2][2][4][2], const pg8::Unit& u, int wr, int wc, int fr, int fq) const {
        const int row0 = u.pm * 256 + wr * 64 + fr, col0 = u.pn * 256 + wc * 32 + 8 * fq;
#pragma unroll
        for (int ai = 0; ai < 2; ++ai)
#pragma unroll
            for (int m = 0; m < 4; ++m) { bf16* rowp = O + (size_t)(row0 + ai * 128 + m * 16) * ldc + col0;
#pragma unroll
                for (int bj = 0; bj < 2; ++bj) { f32x4 v0 = acc[ai][bj][m][0], v1 = acc[ai][bj][m][1];
#pragma unroll
                    for (int j = 0; j < 4; ++j) { const float a = fmaxf(v0[j], 0.f), b = fmaxf(v1[j], 0.f); v0[j] = a * a; v1[j] = b * b; }
                    v4u w; w.x = pg8::cvt_pk_bf16(v0[0], v0[1]); w.y = pg8::cvt_pk_bf16(v0[2], v0[3]); w.z = pg8::cvt_pk_bf16(v1[0], v1[1]); w.w = pg8::cvt_pk_bf16(v1[2], v1[3]);
                    *(v4u*)(rowp + bj * 128) = w; } }
    }
};

__device__ __forceinline__ void p0_prologue(Frame& F) {
    transpose_matrix(F, F.w_in, D, NIN, F.WIN);
    transpose_matrix(F, F.w_out, D, D, F.WOUT);
    const int gw = F.vcu * NWAVES + F.wave, NGW = F.G * NWAVES;
    for (int m = gw; m < M; m += NGW) rms_row<16, true>(F.x + (size_t)m * D, F.g_attn, F.XN + (size_t)m * D, F.lane);
    for (int e = (F.vcu * NWAVES + F.wave) * 64 + F.lane; e < T * 128; e += NGW * 64) {
        const int pos = e >> 7, i = e & 127;
        const double inv = exp2(-(double)i * 0.10381025296523007);
        const double rev = (double)pos * inv * 0.15915494309189535;
        const float fr = (float)(rev - floor(rev));
        F.ROPE[e] = __builtin_amdgcn_cosf(fr); F.ROPE[(size_t)T * 128 + e] = __builtin_amdgcn_sinf(fr);
    }
}

__device__ __forceinline__ void sb_naive_phase(Frame& F) {
    const int gw = F.vcu * NWAVES + F.wave, NGW = F.G * NWAVES;
    const int lane = F.lane, ql = lane >> 2, part = lane & 3;
    for (int w = gw; w < 32 * 512; w += NGW) {
        const int bh = w & 31; const int j = (w >> 5) / 64, g0 = (w >> 5) % 64;
        const int grp = (j & 1) ? 511 - (g0 + 64 * (j - 1)) : g0 + 64 * j;
        const int b = bh >> 4, h = bh & 15, t0 = grp * 16, t = t0 + ql;
        const bf16* base = F.PROJ + (size_t)b * T * NIN + h * SBD + part * 32;
        float q[32], o[32];
        { const GAS v4u* qp = (const GAS v4u*)(base + (size_t)t * NIN + C_SBQ);
#pragma unroll
          for (int c = 0; c < 4; ++c) { const v4u v = qp[c];
              q[8 * c + 0] = bf_lo(v.x); q[8 * c + 1] = bf_hi(v.x); q[8 * c + 2] = bf_lo(v.y); q[8 * c + 3] = bf_hi(v.y);
              q[8 * c + 4] = bf_lo(v.z); q[8 * c + 5] = bf_hi(v.z); q[8 * c + 6] = bf_lo(v.w); q[8 * c + 7] = bf_hi(v.w); } }
#pragma unroll
        for (int i = 0; i < 32; ++i) o[i] = 0.f;
        float R = 1.f;
        for (int s = t0 + 14; s >= 0; --s) {
            const GAS v4u* kp = (const GAS v4u*)(base + (size_t)s * NIN + C_SBK);
            const GAS v4u* vp = (const GAS v4u*)(base + (size_t)s * NIN + C_SBV);
            v4u kv[4], vv[4];
#pragma unroll
            for (int c = 0; c < 4; ++c) { kv[c] = kp[c]; vv[c] = vp[c]; }
            float dot = 0.f;
#pragma unroll
            for (int c = 0; c < 4; ++c) {
                dot += q[8 * c + 0] * bf_lo(kv[c].x) + q[8 * c + 1] * bf_hi(kv[c].x) + q[8 * c + 2] * bf_lo(kv[c].y) + q[8 * c + 3] * bf_hi(kv[c].y)
                     + q[8 * c + 4] * bf_lo(kv[c].z) + q[8 * c + 5] * bf_hi(kv[c].z) + q[8 * c + 6] * bf_lo(kv[c].w) + q[8 * c + 7] * bf_hi(kv[c].w); }
            dot += __shfl_xor(dot, 1); dot += __shfl_xor(dot, 2);
            const float z2 = fminf(fmaxf(dot, -100.f), 100.f);
            const float e = __builtin_amdgcn_exp2f(-z2), beta = 1.f / (1.f + e), omb = e * beta;
            const bool valid = s < t;
            const float a = valid ? beta * R : 0.f; R = valid ? R * omb : R;
#pragma unroll
            for (int c = 0; c < 4; ++c) {
                o[8 * c + 0] += a * bf_lo(vv[c].x); o[8 * c + 1] += a * bf_hi(vv[c].x); o[8 * c + 2] += a * bf_lo(vv[c].y); o[8 * c + 3] += a * bf_hi(vv[c].y);
                o[8 * c + 4] += a * bf_lo(vv[c].z); o[8 * c + 5] += a * bf_hi(vv[c].z); o[8 * c + 6] += a * bf_lo(vv[c].w); o[8 * c + 7] += a * bf_hi(vv[c].w); }
        }
        GAS f32x4* op = (GAS f32x4*)(F.SBO + (size_t)(b * T + t) * 2048 + h * SBD + part * 32);
#pragma unroll
        for (int c = 0; c < 8; ++c) op[c] = (f32x4){o[4 * c], o[4 * c + 1], o[4 * c + 2], o[4 * c + 3]};
    }
}

__device__ __forceinline__ void ret_naive_phase(Frame& F) {
    const int gw = F.vcu * NWAVES + F.wave, NGW = F.G * NWAVES;
    const int lane = F.lane, ql = lane >> 4, part = lane & 15;
    for (int w = gw; w < 16 * 2048; w += NGW) {
        const int bh = w & 15; const int j = (w >> 4) / 128, g0 = (w >> 4) % 128;
        const int grp = (j & 1) ? 2047 - (g0 + 128 * (j - 1)) : g0 + 128 * j;
        const int b = bh >> 3, h = bh & 7, t0 = grp * 4, t = t0 + ql;
        const bf16* base = F.PROJ + (size_t)b * T * NIN + h * RD + part * 16;
        const float Lc = c_log2g[h] * 256.f;
        float q[16], o[16];
        { const GAS v4u* qp = (const GAS v4u*)(base + (size_t)t * NIN + C_RQ);
#pragma unroll
          for (int c = 0; c < 2; ++c) { const v4u v = qp[c];
              q[8 * c + 0] = bf_lo(v.x); q[8 * c + 1] = bf_hi(v.x); q[8 * c + 2] = bf_lo(v.y); q[8 * c + 3] = bf_hi(v.y);
              q[8 * c + 4] = bf_lo(v.z); q[8 * c + 5] = bf_hi(v.z); q[8 * c + 6] = bf_lo(v.w); q[8 * c + 7] = bf_hi(v.w); } }
#pragma unroll
        for (int i = 0; i < 16; ++i) o[i] = 0.f;
        const int ct = t >> 8;
        for (int s = t0 + 3; s >= 0; --s) {
            const GAS v4u* kp = (const GAS v4u*)(base + (size_t)s * NIN + C_RK);
            const GAS v4u* vp = (const GAS v4u*)(base + (size_t)s * NIN + C_RV);
            v4u kv[2], vv[2];
#pragma unroll
            for (int c = 0; c < 2; ++c) { kv[c] = kp[c]; vv[c] = vp[c]; }
            float dot = 0.f;
#pragma unroll
            for (int c = 0; c < 2; ++c) {
                dot += q[8 * c + 0] * bf_lo(kv[c].x) + q[8 * c + 1] * bf_hi(kv[c].x) + q[8 * c + 2] * bf_lo(kv[c].y) + q[8 * c + 3] * bf_hi(kv[c].y)
                     + q[8 * c + 4] * bf_lo(kv[c].z) + q[8 * c + 5] * bf_hi(kv[c].z) + q[8 * c + 6] * bf_lo(kv[c].w) + q[8 * c + 7] * bf_hi(kv[c].w); }
            dot += __shfl_xor(dot, 1); dot += __shfl_xor(dot, 2); dot += __shfl_xor(dot, 4); dot += __shfl_xor(dot, 8);
            const float cw = __builtin_amdgcn_exp2f(Lc * (float)(ct - (s >> 8)));
            const float a = (s <= t) ? dot * cw : 0.f;
#pragma unroll
            for (int c = 0; c < 2; ++c) {
                o[8 * c + 0] += a * bf_lo(vv[c].x); o[8 * c + 1] += a * bf_hi(vv[c].x); o[8 * c + 2] += a * bf_lo(vv[c].y); o[8 * c + 3] += a * bf_hi(vv[c].y);
                o[8 * c + 4] += a * bf_lo(vv[c].z); o[8 * c + 5] += a * bf_hi(vv[c].z); o[8 * c + 6] += a * bf_lo(vv[c].w); o[8 * c + 7] += a * bf_hi(vv[c].w); }
        }
        float s1 = 0.f;
#pragma unroll
        for (int i = 0; i < 16; ++i) s1 += o[i];
        s1 += __shfl_xor(s1, 1); s1 += __shfl_xor(s1, 2); s1 += __shfl_xor(s1, 4); s1 += __shfl_xor(s1, 8);
        const float mu = s1 * (1.f / 256.f); float s2 = 0.f;
#pragma unroll
        for (int i = 0; i < 16; ++i) { o[i] -= mu; s2 += o[i] * o[i]; }
        s2 += __shfl_xor(s2, 1); s2 += __shfl_xor(s2, 2); s2 += __shfl_xor(s2, 4); s2 += __shfl_xor(s2, 8);
        const float rstd = 1.0f / sqrtf(s2 * (1.f / 256.f) + EPS);
        const GAS v4u* gp = (const GAS v4u*)(base + (size_t)t * NIN + C_RG);
        const float* gn = F.g_ret + h * RD + part * 16;
        float gt[16];
#pragma unroll
        for (int c = 0; c < 2; ++c) { const v4u v = gp[c];
            gt[8 * c + 0] = bf_lo(v.x); gt[8 * c + 1] = bf_hi(v.x); gt[8 * c + 2] = bf_lo(v.y); gt[8 * c + 3] = bf_hi(v.y);
            gt[8 * c + 4] = bf_lo(v.z); gt[8 * c + 5] = bf_hi(v.z); gt[8 * c + 6] = bf_lo(v.w); gt[8 * c + 7] = bf_hi(v.w); }
        float y[16];
#pragma unroll
        for (int i = 0; i < 16; ++i) y[i] = o[i] * rstd * gn[i] * gt[i];
        GAS v4u* mp = (GAS v4u*)(F.MIX + (size_t)(b * T + t) * D + 2048 + h * RD + part * 16);
#pragma unroll
        for (int c = 0; c < 2; ++c) { v4u wv; wv.x = pk2(y[8 * c], y[8 * c + 1]); wv.y = pk2(y[8 * c + 2], y[8 * c + 3]); wv.z = pk2(y[8 * c + 4], y[8 * c + 5]); wv.w = pk2(y[8 * c + 6], y[8 * c + 7]); mp[c] = wv; }
    }
}

struct Args { const float* in[10]; float* out; unsigned char* ws; int ph_lo, ph_hi, li, pad; };
__global__ void __launch_bounds__(NWAVES * 64, 2) hymba_fwd(Args args) {
    extern __shared__ __attribute__((aligned(16))) unsigned char lds[];
    Frame F;
    F.lds = (LAS unsigned char*)lds;
    F.MISC = (volatile LAS unsigned*)(F.lds + MISC_OFF);
    F.tid = threadIdx.x; F.lane = F.tid & 63; F.wave = __builtin_amdgcn_readfirstlane(F.tid >> 6);
    F.G = gridDim.x; { const int bx = blockIdx.x; F.vcu = (F.G % 8 == 0) ? (bx % 8) * (F.G / 8) + bx / 8 : bx; }
    unsigned char* ws = args.ws;
    F.ctl = (gu32*)(ws + WS_CTL);
    F.x = args.in[0]; F.g_attn = args.in[1]; F.w_in = args.in[2]; F.g_sb = args.in[3]; F.g_ret = args.in[4]; F.w_out = args.in[5];
    F.g_mlp = args.in[6]; F.w_up = args.in[7]; F.w_down = args.in[8]; F.g_fin = args.in[9]; F.out = args.out;
    F.XN = (bf16*)(ws + WS_XN); F.WIN = (bf16*)(ws + WS_WIN); F.WOUT = (bf16*)(ws + WS_WOUT); F.PROJ = (bf16*)(ws + WS_PROJ); F.MIX = (bf16*)(ws + WS_MIX);
    F.WUP = (bf16*)(ws + WS_WUP); F.HID = (bf16*)(ws + WS_HID); F.WDOWN = (bf16*)(ws + WS_WDOWN);
    F.SBO = (float*)(ws + WS_XN); F.ROPE = (float*)(ws + WS_ROPE);
    for (int u = F.tid; u < (LDS_BYTES - LDSCTL_OFF) / 4; u += NWAVES * 64) ((LAS unsigned*)(F.lds + LDSCTL_OFF))[u] = 0u;
    __syncthreads();
    XcdBarrier bar; bar.bar = (unsigned*)(F.ctl + CW_BAR); bar.x = 0; bar.st = nullptr;
    if (N_LAUNCHES != PER_PHASE) bar = xcd_barrier_post((unsigned*)(F.ctl + CW_BAR) + args.li * XCD_BAR_WORDS, F.MISC + 8);
#define GRID_BAR(seam) do { if (N_LAUNCHES == PER_PHASE) { if (F.tid == 0) __hip_atomic_store(F.ctl + CW_TMO, 0xBADBA0u | (unsigned)(seam), RLX_AGENT); } \
    else { xcd_barrier(bar); } } while (0)
    const int lo = args.ph_lo, hi = args.ph_hi;
#define IN(k) (lo <= (k) && (k) < hi)
#define BOTH(k) (IN(k) && IN((k) + 1))
    const int gw = F.vcu * NWAVES + F.wave, NGW = F.G * NWAVES;

    if (IN(0)) { p0_prologue(F); if (BOTH(0)) GRID_BAR(0); }
    if (IN(1)) {
        pg8::Gemm g{F.XN, F.WIN, M, NIN, D}; pg8::StaticOrder S; S.init(M, NIN, F.G, (int)blockIdx.x);
        EpiProj E{F.PROJ, F.ROPE};
        pg8::gemm_phase<EpiProj, pg8::StaticOrder, true, true>(F.lds + RING_OFF, g, S, E);
        if (BOTH(1)) GRID_BAR(1);
    }
    if (IN(2)) { if (BOTH(2)) GRID_BAR(2); }
    if (IN(3)) { if (BOTH(3)) GRID_BAR(3); }
    if (IN(4)) { sb_naive_phase(F); ret_naive_phase(F); if (BOTH(4)) GRID_BAR(4); }
    if (IN(5)) {
        for (int m = gw; m < M; m += NGW) rms_row<8, true>(F.SBO + (size_t)m * 2048, F.g_sb, F.MIX + (size_t)m * D, F.lane);
        if (BOTH(5)) GRID_BAR(5);
    }
    if (IN(6)) {
        pg8::Gemm g{F.MIX, F.WOUT, M, D, D}; pg8::StaticOrder S; S.init(M, D, F.G, (int)blockIdx.x);
        EpiResF32 E{F.x, F.out, D};
        pg8::gemm_phase<EpiResF32, pg8::StaticOrder, true, true>(F.lds + RING_OFF, g, S, E);
        if (BOTH(6)) GRID_BAR(6);
    }
    if (IN(7)) {
        for (int m = gw; m < M; m += NGW) rms_row<16, true>(F.out + (size_t)m * D, F.g_mlp, F.XN + (size_t)m * D, F.lane);
        transpose_matrix(F, F.w_up, D, FF, F.WUP);
        transpose_matrix(F, F.w_down, FF, D, F.WDOWN);
        if (BOTH(7)) GRID_BAR(7);
    }
    if (IN(8)) {
        pg8::Gemm g{F.XN, F.WUP, M, FF, D}; pg8::StaticOrder S; S.init(M, FF, F.G, (int)blockIdx.x);
        EpiRelu2 E{F.HID, FF};
        pg8::gemm_phase<EpiRelu2, pg8::StaticOrder, true, true>(F.lds + RING_OFF, g, S, E);
        if (BOTH(8)) GRID_BAR(8);
    }
    if (IN(9)) {
        pg8::Gemm g{F.HID, F.WDOWN, M, D, FF}; pg8::StaticOrder S; S.init(M, D, F.G, (int)blockIdx.x);
        EpiResF32 E{F.out, F.out, D};
        pg8::gemm_phase<EpiResF32, pg8::StaticOrder, true, true>(F.lds + RING_OFF, g, S, E);
        if (BOTH(9)) GRID_BAR(9);
    }
    if (IN(10)) {
        for (int m = gw; m < M; m += NGW) rms_row<16, false>(F.out + (size_t)m * D, F.g_fin, F.out + (size_t)m * D, F.lane);
    }
#undef IN
#undef BOTH
}

extern "C" void kernel_launch(void* const* d_in, const int* in_sizes, int n_in, void* d_out, int out_size, void* d_ws, size_t ws_size, hipStream_t stream) {
    static int grid = 0;
    if (grid == 0) {
        if (n_in != 10 || in_sizes[0] != M * D || out_size != M * D || ws_size < WS_END) { fprintf(stderr, "kernel_launch: shape/workspace mismatch (ws %zu, need %zu)\n", ws_size, (size_t)WS_END); grid = -1; return; }
        int dev = 0, cus = 0, per_cu = 0;
        if (hipGetDevice(&dev) != hipSuccess || hipDeviceGetAttribute(&cus, hipDeviceAttributeMultiprocessorCount, dev) != hipSuccess) { grid = -1; return; }
        if (hipFuncSetAttribute((const void*)hymba_fwd, hipFuncAttributeMaxDynamicSharedMemorySize, LDS_BYTES) != hipSuccess) { fprintf(stderr, "kernel_launch: hipFuncSetAttribute failed\n"); grid = -1; return; }
        if (hipOccupancyMaxActiveBlocksPerMultiprocessor(&per_cu, (const void*)hymba_fwd, NWAVES * 64, LDS_BYTES) != hipSuccess || per_cu < 1)
            fprintf(stderr, "kernel_launch: occupancy query reports %d workgroups per CU\n", per_cu);
        (void)hipGetLastError();
        grid = cus;
    }
    if (grid < 0) return;
    if (hipMemsetAsync((char*)d_ws + WS_CTL, 0, CTL_ZERO_BYTES, stream) != hipSuccess) return;
    Args a{};
    for (int i = 0; i < 10; ++i) a.in[i] = (const float*)d_in[i];
    a.out = (float*)d_out; a.ws = (unsigned char*)d_ws;
    if (N_LAUNCHES == 1) {
        a.ph_lo = 0; a.ph_hi = PER_PHASE; a.li = 0;
        hipLaunchKernelGGL(hymba_fwd, dim3(grid), dim3(NWAVES * 64), LDS_BYTES, stream, a);
    } else {
        for (int li = 0; li < PER_PHASE; ++li) {
            if (li == 2 || li == 3) continue;
            a.ph_lo = li; a.ph_hi = li + 1; a.li = 0;
            hipLaunchKernelGGL(hymba_fwd, dim3(grid), dim3(NWAVES * 64), LDS_BYTES, stream, a);
        }
    }
    const hipError_t le = hipPeekAtLastError();
    if (le != hipSuccess) fprintf(stderr, "kernel_launch: launch failed: %s\n", hipGetErrorName(le));
}
```

```cpp
#include <hip/hip_runtime.h>
#include <cstdio>
#include <cstdint>

namespace pg8 {
#define PG8_LAS __attribute__((address_space(3)))
typedef unsigned short bf16_t;
typedef short bf16x8 __attribute__((ext_vector_type(8)));
typedef float f32x4 __attribute__((ext_vector_type(4)));
typedef unsigned u32x4 __attribute__((ext_vector_type(4)));
constexpr int BM = 256, BK = 64, HALF = 128, HTB = HALF * BK * 2, STAGE_BYTES = 8 * HTB, NXCD = 8, WGM = 8;

__host__ __device__ __forceinline__ int lds_byte(int r, int c) { const int st = (r >> 4) * 2 + (c >> 5), rr = r & 15, cc = c & 31, ob = rr * 64 + cc * 2; return st * 1024 + (ob ^ (((ob >> 9) & 1) << 5)); }
__host__ __device__ __forceinline__ void stage_rc(int b, int& R, int& C) { const int st = b / 1024, sb = b % 1024, swz = sb ^ (((sb >> 9) & 1) << 5); R = (st >> 1) * 16 + swz / 64; C = (st & 1) * 32 + (swz % 64) / 2; }
__host__ __device__ __forceinline__ int perm32(int rho) { const int n = rho >> 4, i = rho & 15; return 8 * (i >> 2) + 4 * n + (i & 3); }

struct Unit { int pm, pn; };
struct Gemm { const bf16_t* A; const bf16_t* Bt; int M, N, K; };

struct StaticOrder {
    int nM, nN, nwg, G, c;
    __host__ __device__ void init(int M, int N, int G_, int c_) { nM = M / BM; nN = N / BM; nwg = nM * nN; G = G_; c = c_; }
    __host__ __device__ bool next(int i, Unit& u) const {
        const long L = (long)i * G + c; if (L >= nwg) return false;
        int wgid = (int)L; { const int q = nwg / NXCD, r = nwg % NXCD, xcd = wgid % NXCD, off = wgid / NXCD; wgid = (xcd < r ? xcd * (q + 1) : r * (q + 1) + (xcd - r) * q) + off; }
        const int nig = WGM * nN, gid = wgid / nig, fm = gid * WGM, gsz = (nM - fm) < WGM ? (nM - fm) : WGM;
        u.pm = fm + ((wgid % nig) % gsz); u.pn = (wgid % nig) / gsz; return true;
    }
    __device__ __forceinline__ void a_ready(const Unit&) const {}
    __device__ __forceinline__ void done(const Unit&) const {}
};

__device__ __forceinline__ unsigned cvt_pk_bf16(float lo, float hi) { unsigned r; asm volatile("v_cvt_pk_bf16_f32 %0, %1, %2" : "=v"(r) : "v"(lo), "v"(hi)); return r; }

template <class Epi, class Sched, bool ALIGN_EPI = false, bool SP2 = false>
__device__ __forceinline__ void gemm_phase(PG8_LAS unsigned char* lds, const Gemm g, const Sched& S, const Epi& E) {
    const int tid = threadIdx.x, wid = __builtin_amdgcn_readfirstlane(tid >> 6), lane = tid & 63, wr = wid >> 2, wc = wid & 3, fr = lane & 15, fq = lane >> 4;
    const int K = g.K, nt = K / BK;
    unsigned voffA[2], voffB[2];
#pragma unroll
    for (int i = 0; i < 2; ++i) { int R, C; stage_rc(tid * 16 + i * 8192, R, C); const int Rb = Epi::PERM ? ((R & ~31) + perm32(R & 31)) : R;
        voffA[i] = (unsigned)(R * K + C) * 2u; voffB[i] = (unsigned)(Rb * K + C) * 2u; }
    const size_t kstep = (size_t)(BK * 2);
    const size_t hstep = (size_t)HALF * K * 2;
    const size_t tstep = 2 * hstep;
    const unsigned ldsw = (unsigned)wid * 1024u;
    const int aoff = lds_byte(wr * 64 + fr, fq * 8), boff = lds_byte(wc * 32 + fr, fq * 8);
#define PG8_SA(b, h) (((b) * 2 + (h)) * HTB)
#define PG8_SB(b, h) ((4 + (b) * 2 + (h)) * HTB)
#define PG8_STAGE(bufoff, gbase, voff) do { _Pragma("unroll") for (int _i = 0; _i < 2; ++_i) \
        __builtin_amdgcn_global_load_lds((const unsigned*)((const char*)(gbase) + (voff)[_i]), (PG8_LAS unsigned*)(lds + (bufoff) + ldsw + _i * 8192), 16, 0, 0); } while (0)
#define PG8_LDA(dst, b, h) do { _Pragma("unroll") for (int m = 0; m < 4; ++m) _Pragma("unroll") for (int k = 0; k < 2; ++k) dst[m][k] = *(const PG8_LAS bf16x8*)(lds + PG8_SA(b, h) + aoff + m * 2048 + k * 1024); } while (0)
#define PG8_LDB(dst, b, h) do { _Pragma("unroll") for (int n = 0; n < 2; ++n) _Pragma("unroll") for (int k = 0; k < 2; ++k) dst[n][k] = *(const PG8_LAS bf16x8*)(lds + PG8_SB(b, h) + boff + n * 2048 + k * 1024); } while (0)
#define PG8_MMA(ai, bj, At, Bt) do { __builtin_amdgcn_s_setprio(1); _Pragma("unroll") for (int m = 0; m < 4; ++m) _Pragma("unroll") for (int n = 0; n < 2; ++n) _Pragma("unroll") for (int k = 0; k < 2; ++k) \
        acc[ai][bj][m][n] = __builtin_amdgcn_mfma_f32_16x16x32_bf16(Bt[n][k], At[m][k], acc[ai][bj][m][n], 0, 0, 0); __builtin_amdgcn_s_setprio(0); } while (0)
#define PG8_WAIT_V(n) asm volatile("s_waitcnt vmcnt(" #n ")" ::: "memory")
#define PG8_WAIT_L(n) asm volatile("s_waitcnt lgkmcnt(" #n ")" ::: "memory")
#define PG8_BAR __builtin_amdgcn_s_barrier()
#define PG8_SCHED __builtin_amdgcn_sched_barrier(0)
    Unit cur, nxt; int ui = 0;
    if (!S.next(0, cur)) return;
    f32x4 acc[2][2][4][2];
#pragma unroll
    for (int a = 0; a < 2; ++a)
#pragma unroll
        for (int b = 0; b < 2; ++b)
#pragma unroll
            for (int m = 0; m < 4; ++m)
#pragma unroll
                for (int n = 0; n < 2; ++n) acc[a][b][m][n] = (f32x4){0.f, 0.f, 0.f, 0.f};
    bf16x8 At[4][2], B0[2][2], B1[2][2];
    const char* cA = (const char*)g.A + (size_t)cur.pm * tstep; const char* cB = (const char*)g.Bt + (size_t)cur.pn * tstep;
    S.a_ready(cur);
    if constexpr (SP2) {
        PG8_STAGE(PG8_SB(0, 0), cB, voffB); PG8_STAGE(PG8_SB(0, 1), cB + hstep, voffB); PG8_STAGE(PG8_SA(0, 0), cA, voffA); PG8_STAGE(PG8_SA(0, 1), cA + hstep, voffA);
        if (wr == 1) PG8_BAR;
        PG8_WAIT_V(2); PG8_BAR;
        PG8_STAGE(PG8_SB(1, 0), cB + kstep, voffB); PG8_STAGE(PG8_SA(1, 0), cA + kstep, voffA); PG8_STAGE(PG8_SB(1, 1), cB + hstep + kstep, voffB);
        PG8_WAIT_V(6); PG8_BAR;
    } else {
        PG8_STAGE(PG8_SB(0, 0), cB, voffB); PG8_STAGE(PG8_SA(0, 0), cA, voffA); PG8_STAGE(PG8_SB(0, 1), cB + hstep, voffB); PG8_STAGE(PG8_SA(0, 1), cA + hstep, voffA);
        if (wr == 1) PG8_BAR;
        PG8_WAIT_V(4); PG8_BAR;
        PG8_STAGE(PG8_SB(1, 0), cB + kstep, voffB); PG8_STAGE(PG8_SA(1, 0), cA + kstep, voffA); PG8_STAGE(PG8_SB(1, 1), cB + hstep + kstep, voffB);
        PG8_WAIT_V(6); PG8_BAR;
    }
    for (;;) {
        const bool has_next = S.next(ui + 1, nxt);
        const char* nA = has_next ? (const char*)g.A + (size_t)nxt.pm * tstep : cA; const char* nB = has_next ? (const char*)g.Bt + (size_t)nxt.pn * tstep : cB;
        for (int t = 0; t < nt; t += 2) {
            const bool last = (t == nt - 2);
            const char* a1 = cA + (size_t)(t + 1) * kstep;
            const char* a2 = last ? nA : cA + (size_t)(t + 2) * kstep; const char* b2 = last ? nB : cB + (size_t)(t + 2) * kstep;
            const char* a3 = a2 + kstep; const char* b3 = b2 + kstep;
            if (last && has_next) S.a_ready(nxt);
            if constexpr (SP2) {
            PG8_LDB(B0, 0, 0); PG8_LDB(B1, 0, 1); PG8_SCHED; PG8_LDA(At, 0, 0); PG8_STAGE(PG8_SA(1, 1), a1 + hstep, voffA);
            PG8_WAIT_V(8); PG8_WAIT_L(0); PG8_BAR; PG8_MMA(0, 0, At, B0); PG8_MMA(0, 1, At, B1); PG8_BAR; PG8_SCHED;
            PG8_LDA(At, 0, 1); PG8_STAGE(PG8_SB(0, 0), b2, voffB); PG8_STAGE(PG8_SB(0, 1), b2 + hstep, voffB); PG8_STAGE(PG8_SA(0, 0), a2, voffA);
            PG8_WAIT_V(8); PG8_WAIT_L(0); PG8_BAR; PG8_MMA(1, 0, At, B0); PG8_MMA(1, 1, At, B1); PG8_BAR; PG8_SCHED;
            PG8_LDB(B0, 1, 0); PG8_LDB(B1, 1, 1); PG8_SCHED; PG8_LDA(At, 1, 0); PG8_STAGE(PG8_SA(0, 1), a2 + hstep, voffA);
            PG8_WAIT_V(8); PG8_WAIT_L(0); PG8_BAR; PG8_MMA(0, 0, At, B0); PG8_MMA(0, 1, At, B1); PG8_BAR; PG8_SCHED;
            PG8_LDA(At, 1, 1); PG8_STAGE(PG8_SB(1, 0), b3, voffB); PG8_STAGE(PG8_SB(1, 1), b3 + hstep, voffB); PG8_STAGE(PG8_SA(1, 0), a3, voffA);
            PG8_WAIT_V(8); PG8_WAIT_L(0); PG8_BAR; PG8_MMA(1, 0, At, B0); PG8_MMA(1, 1, At, B1); PG8_BAR; PG8_SCHED;
            } else {
            PG8_LDB(B0, 0, 0); PG8_SCHED; PG8_LDA(At, 0, 0); PG8_STAGE(PG8_SA(1, 1), a1 + hstep, voffA);
            PG8_WAIT_L(8); PG8_BAR; PG8_WAIT_L(0); PG8_MMA(0, 0, At, B0); PG8_BAR; PG8_SCHED;
            PG8_LDB(B1, 0, 1); PG8_STAGE(PG8_SB(0, 0), b2, voffB);
            PG8_BAR; PG8_WAIT_L(0); PG8_MMA(0, 1, At, B1); PG8_BAR;
            PG8_LDA(At, 0, 1); PG8_STAGE(PG8_SA(0, 0), a2, voffA);
            PG8_BAR; PG8_WAIT_L(0); PG8_MMA(1, 0, At, B0); PG8_BAR; PG8_SCHED;
            PG8_STAGE(PG8_SB(0, 1), b2 + hstep, voffB);
            PG8_WAIT_V(6); PG8_BAR; PG8_MMA(1, 1, At, B1); PG8_BAR;
            PG8_LDB(B0, 1, 0); PG8_SCHED; PG8_LDA(At, 1, 0); PG8_STAGE(PG8_SA(0, 1), a2 + hstep, voffA);
            PG8_WAIT_L(8); PG8_BAR; PG8_WAIT_L(0); PG8_MMA(0, 0, At, B0); PG8_BAR; PG8_SCHED;
            PG8_LDB(B1, 1, 1); PG8_STAGE(PG8_SB(1, 0), b3, voffB);
            PG8_BAR; PG8_WAIT_L(0); PG8_MMA(0, 1, At, B1); PG8_BAR;
            PG8_LDA(At, 1, 1); PG8_STAGE(PG8_SA(1, 0), a3, voffA);
            PG8_BAR; PG8_WAIT_L(0); PG8_MMA(1, 0, At, B0); PG8_BAR; PG8_SCHED;
            PG8_STAGE(PG8_SB(1, 1), b3 + hstep, voffB);
            PG8_WAIT_V(6); PG8_BAR; PG8_MMA(1, 1, At, B1); PG8_BAR;
            }
        }
        if constexpr (ALIGN_EPI) { if (wr == 0) PG8_BAR; }
        E(acc, cur, wr, wc, fr, fq); S.done(cur);
        if (!has_next) break;
#pragma unroll
        for (int a = 0; a < 2; ++a)
#pragma unroll
            for (int b = 0; b < 2; ++b)
#pragma unroll
                for (int m = 0; m < 4; ++m)
#pragma unroll
                    for (int n = 0; n < 2; ++n) acc[a][b][m][n] = (f32x4){0.f, 0.f, 0.f, 0.f};
        cur = nxt; cA = nA; cB = nB; ++ui;
        if constexpr (ALIGN_EPI) { if (wr == 1) PG8_BAR; }
    }
    PG8_WAIT_V(0);
    if constexpr (!ALIGN_EPI) { if (wr == 0) PG8_BAR; }
    PG8_BAR;
#undef PG8_SA
#undef PG8_SB
#undef PG8_STAGE
#undef PG8_LDA
#undef PG8_LDB
#undef PG8_MMA
#undef PG8_WAIT_V
#undef PG8_WAIT_L
#undef PG8_BAR
#undef PG8_SCHED
}
}

constexpr int NWAVES = 8;
#ifndef MK_N_LAUNCHES
#define MK_N_LAUNCHES 1
#endif
constexpr int PER_PHASE = 11;
constexpr int N_LAUNCHES = MK_N_LAUNCHES;

constexpr int BATCH = 2, T = 8192, D = 4096, M = BATCH * T;
constexpr int SBH = 16, SBD = 128, RH = 8, RD = 256;
constexpr int NIN = 14336, FF = 16384;
constexpr int C_SBQ = 0, C_SBK = 2048, C_SBV = 4096, C_RQ = 6144, C_RK = 8192, C_RV = 10240, C_RG = 12288;
constexpr float EPS = 1e-6f;
constexpr float QSCALE = 0.12751743082459868f;

constexpr size_t MiB = 1u << 20;
constexpr size_t WS_CTL = 0, CTL_ZERO_BYTES = 1 * MiB;
constexpr size_t WS_XN = 1 * MiB;
constexpr size_t WS_WIN = 129 * MiB;
constexpr size_t WS_WOUT = 241 * MiB;
constexpr size_t WS_PROJ = 273 * MiB;
constexpr size_t WS_MIX = 721 * MiB;
constexpr size_t WS_ROPE = 849 * MiB;
constexpr size_t WS_STATE = 857 * MiB;
constexpr size_t WS_WUP = 129 * MiB;
constexpr size_t WS_HID = 273 * MiB;
constexpr size_t WS_WDOWN = 785 * MiB;
constexpr size_t WS_END = 921 * MiB;
constexpr int CW_TMO = 0, CW_CODE = 1, CW_BAR = 4096;

constexpr int RING_OFF = 0, RING_BYTES = 135168;
constexpr int LDSCTL_OFF = RING_BYTES, MISC_OFF = LDSCTL_OFF + 320;
constexpr int LDS_BYTES = 147456;

#define GAS __attribute__((address_space(1)))
#define LAS __attribute__((address_space(3)))
typedef unsigned short bf16;
typedef unsigned v4u __attribute__((ext_vector_type(4)));
typedef unsigned v2u __attribute__((ext_vector_type(2)));
typedef float f32x4 __attribute__((ext_vector_type(4)));
typedef GAS unsigned gu32;
#define RLX_AGENT __ATOMIC_RELAXED, __HIP_MEMORY_SCOPE_AGENT
#define LDS_WAIT() asm volatile("s_waitcnt lgkmcnt(0)" ::: "memory")
#define VM_WAIT() asm volatile("s_waitcnt vmcnt(0)" ::: "memory")
__device__ __forceinline__ unsigned f2bf(float f) { unsigned u = __builtin_bit_cast(unsigned, f); return (u + 0x7fffu + ((u >> 16) & 1u)) >> 16; }
__device__ __forceinline__ unsigned pk2(float lo, float hi) { return f2bf(lo) | (f2bf(hi) << 16); }
__device__ __forceinline__ float bf_lo(unsigned w) { return __builtin_bit_cast(float, w << 16); }
__device__ __forceinline__ float bf_hi(unsigned w) { return __builtin_bit_cast(float, w & 0xffff0000u); }

#define XB_TMO      128
#define XB_XCNT(j)  (256  + 64 * (j))
#define XB_XSUB(j)  (1280 + 64 * (j))
#define XB_XGEN(j)  (2304 + 64 * (j))
#define XB_TOP      3328
#define XB_TOPGEN   3392
#define XCD_BAR_WORDS 3456
#define XB_SPIN_CAP (1u << 18)

__device__ __forceinline__ unsigned xb_ld(unsigned* p)              { return __hip_atomic_load(p, __ATOMIC_RELAXED, __HIP_MEMORY_SCOPE_AGENT); }
__device__ __forceinline__ unsigned xb_add(unsigned* p, unsigned v) { return __hip_atomic_fetch_add(p, v, __ATOMIC_RELAXED, __HIP_MEMORY_SCOPE_AGENT); }
__device__ __forceinline__ unsigned xb_xcc_id() { return (unsigned)__builtin_amdgcn_s_getreg((3 << 11) | 20) & 0xFu; }
#define XB_SPIN(cond, bar) do { unsigned _sp = 0; while (cond) { __builtin_amdgcn_s_sleep(1); \
    if ((++_sp & 255u) == 0u) { if (xb_ld(&(bar)[XB_TMO])) break; if (_sp > XB_SPIN_CAP) { atomicAdd(&(bar)[XB_TMO], 1u); break; } } } } while (0)

struct XcdBarrier {
    unsigned* bar; unsigned x;
    volatile LAS unsigned* st;
};
__device__ __forceinline__ XcdBarrier xcd_barrier_post(unsigned* bar, volatile LAS unsigned* st) {
    XcdBarrier b; b.bar = bar; b.x = xb_xcc_id(); b.st = st;
    if (threadIdx.x == 0) (void)xb_add(&bar[XB_XCNT(b.x)], 1u);
    return b;
}
__device__ __forceinline__ void xcd_barrier_complete(unsigned* bar, unsigned x, unsigned& nloc, unsigned& nx) {
    const unsigned G = gridDim.x * gridDim.y * gridDim.z;
    unsigned sum, cnt, mine, sp = 0u;
    for (;;) {
        sum = 0u; cnt = 0u; mine = 0u;
#pragma unroll
        for (unsigned j = 0; j < 16; ++j) { const unsigned c = xb_ld(&bar[XB_XCNT(j)]); sum += c; cnt += (c > 0u) ? 1u : 0u; mine = (j == x) ? c : mine; }
        if (sum == G) break;
        __builtin_amdgcn_s_sleep(1);
        if ((++sp & 255u) == 0u) { if (xb_ld(&bar[XB_TMO])) break; if (sp > XB_SPIN_CAP) { atomicAdd(&bar[XB_TMO], 1u); break; } }
    }
    nloc = mine > 0u ? mine : 1u; nx = cnt > 0u ? cnt : 1u;
}
__device__ __forceinline__ void xcd_barrier(const XcdBarrier& b) {
    asm volatile("s_waitcnt vmcnt(0)" ::: "memory");
    __syncthreads();
    if (threadIdx.x == 0) {
        unsigned* bar = b.bar;
        __builtin_amdgcn_s_waitcnt(0);
        unsigned nloc = b.st[0], nx = b.st[1];
        if (nloc == 0u) { xcd_barrier_complete(bar, b.x, nloc, nx); b.st[0] = nloc; b.st[1] = nx; }
        const unsigned old = xb_add(&bar[XB_XSUB(b.x)], 1u);
        const unsigned gen = old / nloc;
        if (old + 1u == (gen + 1u) * nloc) {
            __builtin_amdgcn_fence(__ATOMIC_RELEASE, "agent");
            asm volatile("s_waitcnt vmcnt(0)" ::: "memory");
            const unsigned og = xb_add(&bar[XB_TOP], 1u);
            const unsigned tg = og / nx;
            if (og + 1u == (tg + 1u) * nx) xb_add(&bar[XB_TOPGEN], 1u);
            else XB_SPIN(xb_ld(&bar[XB_TOPGEN]) == tg, bar);
            __builtin_amdgcn_fence(__ATOMIC_ACQUIRE, "agent");
            xb_add(&bar[XB_XGEN(b.x)], 1u);
            asm volatile("s_waitcnt vmcnt(0)" ::: "memory");
        } else {
            XB_SPIN(xb_ld(&bar[XB_XGEN(b.x)]) == gen, bar);
            __builtin_amdgcn_fence(__ATOMIC_ACQUIRE, "agent");
            asm volatile("s_waitcnt vmcnt(0)" ::: "memory");
        }
    }
    __syncthreads();
}

struct Frame {
    LAS unsigned char* lds;
    volatile LAS unsigned* MISC;
    gu32* ctl;
    int tid, lane, wave;
    int vcu, G;
    const float* x; float* out;
    const float *g_attn, *w_in, *g_sb, *g_ret, *w_out, *g_mlp, *w_up, *w_down, *g_fin;
    bf16 *XN, *WIN, *WOUT, *PROJ, *MIX, *WUP, *HID, *WDOWN;
    float *SBO, *ROPE, *UT; bf16* ST;
};

__device__ __forceinline__ float wave_sum(float v) {
#pragma unroll
    for (int o = 1; o < 64; o <<= 1) v += __shfl_xor(v, o);
    return v;
}
__device__ __forceinline__ void p0_transpose_item(const float* W, int K, int N, bf16* WT, LAS float* scr, int item, int lane) {
    const int nblk = N / 32, kb = item / nblk, nb = item % nblk, k0 = 64 * kb, n0 = 32 * nb;
#pragma unroll 8
    for (int i = 0; i < 32; ++i) { const int kk = 2 * i + (lane >> 5); scr[kk * 33 + (lane & 31)] = W[(size_t)(k0 + kk) * N + n0 + (lane & 31)]; }
    LDS_WAIT(); asm volatile("" ::: "memory");
    const int c = lane & 7;
#pragma unroll
    for (int j = 0; j < 4; ++j) { const int n = (lane >> 3) + 8 * j; const LAS float* s = scr + (8 * c) * 33 + n;
        v4u o; o.x = pk2(s[0 * 33], s[1 * 33]); o.y = pk2(s[2 * 33], s[3 * 33]); o.z = pk2(s[4 * 33], s[5 * 33]); o.w = pk2(s[6 * 33], s[7 * 33]);
        *(GAS v4u*)(WT + (size_t)(n0 + n) * K + k0 + 8 * c) = o; }
    LDS_WAIT(); asm volatile("" ::: "memory");
}
__device__ __forceinline__ void transpose_matrix(Frame& F, const float* W, int K, int N, bf16* WT) {
    LAS float* scr = (LAS float*)(F.lds + RING_OFF + F.wave * 16384);
    const int gw = F.vcu * NWAVES + F.wave, NGW = F.G * NWAVES;
    const int nitems = (K / 64) * (N / 32);
    for (int it = gw; it < nitems; it += NGW) p0_transpose_item(W, K, N, WT, scr, it, F.lane);
}
template <int NJ, bool OUT_BF16>
__device__ __forceinline__ void rms_row(const float* xrow, const float* g, void* orow, int lane) {
    const GAS f32x4* xr = (const GAS f32x4*)xrow + lane;
    f32x4 v[NJ]; float s = 0.f;
#pragma unroll
    for (int j = 0; j < NJ; ++j) { v[j] = xr[64 * j]; s += (v[j].x * v[j].x + v[j].y * v[j].y) + (v[j].z * v[j].z + v[j].w * v[j].w); }
    const float rstd = 1.0f / sqrtf(wave_sum(s) * (1.f / (256.f * NJ)) + EPS);
    const GAS f32x4* gr = (const GAS f32x4*)g + lane;
#pragma unroll
    for (int j = 0; j < NJ; ++j) { const f32x4 gg = gr[64 * j]; const f32x4 y = v[j] * rstd * gg;
        if constexpr (OUT_BF16) { v2u o; o.x = pk2(y.x, y.y); o.y = pk2(y.z, y.w); ((GAS v2u*)orow)[lane + 64 * j] = o; }
        else ((GAS f32x4*)orow)[lane + 64 * j] = y; }
}

__constant__ float c_log2g[8] = { -0.04580368961312479f, -0.02272007650008353f, -0.011315313227834146f, -0.005646563141142063f,
                                  -0.0028205190623786626f, -0.0014095702546713536f, -0.0007046129765893727f, -0.0003522634716290214f };
struct EpiProj {
    static constexpr bool PERM = true, AFTER_DRAIN = false;
    bf16* O; const float* rope;
    __device__ __forceinline__ void operator()(const pg8::f32x4 (&acc)[2][2][4][2], const pg8::Unit& u, int wr, int wc, int fr, int fq) const {
        const int kind = u.pn >> 3;
        const int row0 = u.pm * 256 + wr * 64 + fr, col0 = u.pn * 256 + wc * 32 + 8 * fq;
        if (kind == 3 || kind == 4) {
            const float L = c_log2g[u.pn & 7] * (kind == 3 ? 1.f : -1.f), mul = (kind == 3) ? 1.f : 0.0625f;
            const int i0 = wc * 32 + 8 * fq;
#pragma unroll
            for (int ai = 0; ai < 2; ++ai)
#pragma unroll
                for (int m = 0; m < 4; ++m) {
                    const int row = row0 + ai * 128 + m * 16, pos = row & (T - 1), tl = row & 255;
                    const float sc = __builtin_amdgcn_exp2f((float)(tl + 1) * L) * mul;
                    const float* cp = rope + (size_t)pos * 128 + i0; const float* sp = cp + (size_t)T * 128;
                    const f32x4 c0 = *(const f32x4*)cp, c1 = *(const f32x4*)(cp + 4), s0 = *(const f32x4*)sp, s1 = *(const f32x4*)(sp + 4);
                    const f32x4 a0 = acc[ai][0][m][0], a1 = acc[ai][0][m][1], b0 = acc[ai][1][m][0], b1 = acc[ai][1][m][1];
                    const f32x4 y0 = (a0 * c0 - b0 * s0) * sc, y1 = (a1 * c1 - b1 * s1) * sc, z0 = (b0 * c0 + a0 * s0) * sc, z1 = (b1 * c1 + a1 * s1) * sc;
                    bf16* rowp = O + (size_t)row * NIN + col0;
                    v4u w; w.x = pg8::cvt_pk_bf16(y0[0], y0[1]); w.y = pg8::cvt_pk_bf16(y0[2], y0[3]); w.z = pg8::cvt_pk_bf16(y1[0], y1[1]); w.w = pg8::cvt_pk_bf16(y1[2], y1[3]);
                    *(v4u*)rowp = w;
                    v4u w2; w2.x = pg8::cvt_pk_bf16(z0[0], z0[1]); w2.y = pg8::cvt_pk_bf16(z0[2], z0[3]); w2.z = pg8::cvt_pk_bf16(z1[0], z1[1]); w2.w = pg8::cvt_pk_bf16(z1[2], z1[3]);
                    *(v4u*)(rowp + 128) = w2;
                }
        } else {
            const float sc = (kind == 0) ? QSCALE : 1.f;
#pragma unroll
            for (int ai = 0; ai < 2; ++ai)
#pragma unroll
                for (int m = 0; m < 4; ++m) { bf16* rowp = O + (size_t)(row0 + ai * 128 + m * 16) * NIN + col0;
#pragma unroll
                    for (int bj = 0; bj < 2; ++bj) { f32x4 v0 = acc[ai][bj][m][0] * sc, v1 = acc[ai][bj][m][1] * sc;
                        if (kind == 6) {
#pragma unroll
                            for (int j = 0; j < 4; ++j) { v0[j] = v0[j] * __builtin_amdgcn_rcpf(1.f + __builtin_amdgcn_exp2f(-1.4426950408889634f * v0[j]));
                                                          v1[j] = v1[j] * __builtin_amdgcn_rcpf(1.f + __builtin_amdgcn_exp2f(-1.4426950408889634f * v1[j])); } }
                        v4u w; w.x = pg8::cvt_pk_bf16(v0[0], v0[1]); w.y = pg8::cvt_pk_bf16(v0[2], v0[3]); w.z = pg8::cvt_pk_bf16(v1[0], v1[1]); w.w = pg8::cvt_pk_bf16(v1[2], v1[3]);
                        *(v4u*)(rowp + bj * 128) = w; } }
        }
    }
};
struct EpiResF32 {
    static constexpr bool PERM = false, AFTER_DRAIN = false;
    const float* base; float* out; int ldc;
    __device__ __forceinline__ void operator()(const pg8::f32x4 (&acc)[2][2][4][2], const pg8::Unit& u, int wr, int wc, int fr, int fq) const {
        const int row0 = u.pm * 256 + wr * 64 + fr, col0 = u.pn * 256 + wc * 32 + 4 * fq;
#pragma unroll
        for (int ai = 0; ai < 2; ++ai)
#pragma unroll
            for (int m = 0; m < 4; ++m) { const size_t off = (size_t)(row0 + ai * 128 + m * 16) * ldc + col0;
#pragma unroll
                for (int bj = 0; bj < 2; ++bj)
#pragma unroll
                    for (int n = 0; n < 2; ++n) { const f32x4 b = *(const f32x4*)(base + off + bj * 128 + n * 16); *(f32x4*)(out + off + bj * 128 + n * 16) = b + acc[ai][bj][m][n]; } }
    }
};
struct EpiRelu2 {
    static constexpr bool PERM = true, AFTER_DRAIN = false;
    bf16* O; int ldc;
    __device__ __forceinline__ void operator()(const pg8::f32x4 (&acc)[2][2][4][2], const pg8::Unit& u, int wr, int wc, int fr, int fq) const {
        const int row0 = u.pm * 256 + wr * 64 + fr, col0 = u.pn * 256 + wc * 32 + 8 * fq;
#pragma unroll
        for (int ai = 0; ai < 2; ++ai)
#pragma unroll
            for (int m = 0; m < 4; ++m) { bf16* rowp = O + (size_t)(row0 + ai * 128 + m * 16) * ldc + col0;
#pragma unroll
                for (int bj = 0; bj < 2; ++bj) { f32x4 v0 = acc[ai][bj][m][0], v1 = acc[ai][bj][m][1];
#pragma unroll
                    for (int j = 0; j < 4; ++j) { const float a = fmaxf(v0[j], 0.f), b = fmaxf(v1[j], 0.f); v0[j] = a * a; v1[j] = b * b; }
                    v4u w; w.x = pg8::cvt_pk_bf16(v0[0], v0[1]); w.y = pg8::cvt_pk_bf16(v0[2], v0[3]); w.z = pg8::cvt_pk_bf16(v1[0], v1[1]); w.w = pg8::cvt_pk_bf16(v1[2], v1[3]);
                    *(v4u*)(rowp + bj * 128) = w; } }
    }
};

__device__ __forceinline__ void p0_prologue(Frame& F) {
    transpose_matrix(F, F.w_in, D, NIN, F.WIN);
    transpose_matrix(F, F.w_out, D, D, F.WOUT);
    const int gw = F.vcu * NWAVES + F.wave, NGW = F.G * NWAVES;
    for (int m = gw; m < M; m += NGW) rms_row<16, true>(F.x + (size_t)m * D, F.g_attn, F.XN + (size_t)m * D, F.lane);
    for (int e = (F.vcu * NWAVES + F.wave) * 64 + F.lane; e < T * 128; e += NGW * 64) {
        const int pos = e >> 7, i = e & 127;
        const double inv = exp2(-(double)i * 0.10381025296523007);
        const double rev = (double)pos * inv * 0.15915494309189535;
        const float fr = (float)(rev - floor(rev));
        F.ROPE[e] = __builtin_amdgcn_cosf(fr); F.ROPE[(size_t)T * 128 + e] = __builtin_amdgcn_sinf(fr);
    }
}

__device__ __forceinline__ void sb_naive_phase(Frame& F) {
    const int gw = F.vcu * NWAVES + F.wave, NGW = F.G * NWAVES;
    const int lane = F.lane, ql = lane >> 2, part = lane & 3;
    for (int w = gw; w < 32 * 512; w += NGW) {
        const int bh = w & 31; const int j = (w >> 5) / 64, g0 = (w >> 5) % 64;
        const int grp = (j & 1) ? 511 - (g0 + 64 * (j - 1)) : g0 + 64 * j;
        const int b = bh >> 4, h = bh & 15, t0 = grp * 16, t = t0 + ql;
        const bf16* base = F.PROJ + (size_t)b * T * NIN + h * SBD + part * 32;
        float q[32], o[32];
        { const GAS v4u* qp = (const GAS v4u*)(base + (size_t)t * NIN + C_SBQ);
#pragma unroll
          for (int c = 0; c < 4; ++c) { const v4u v = qp[c];
              q[8 * c + 0] = bf_lo(v.x); q[8 * c + 1] = bf_hi(v.x); q[8 * c + 2] = bf_lo(v.y); q[8 * c + 3] = bf_hi(v.y);
              q[8 * c + 4] = bf_lo(v.z); q[8 * c + 5] = bf_hi(v.z); q[8 * c + 6] = bf_lo(v.w); q[8 * c + 7] = bf_hi(v.w); } }
#pragma unroll
        for (int i = 0; i < 32; ++i) o[i] = 0.f;
        float R = 1.f;
        for (int s = t0 + 14; s >= 0; --s) {
            const GAS v4u* kp = (const GAS v4u*)(base + (size_t)s * NIN + C_SBK);
            const GAS v4u* vp = (const GAS v4u*)(base + (size_t)s * NIN + C_SBV);
            v4u kv[4], vv[4];
#pragma unroll
            for (int c = 0; c < 4; ++c) { kv[c] = kp[c]; vv[c] = vp[c]; }
            float dot = 0.f;
#pragma unroll
            for (int c = 0; c < 4; ++c) {
                dot += q[8 * c + 0] * bf_lo(kv[c].x) + q[8 * c + 1] * bf_hi(kv[c].x) + q[8 * c + 2] * bf_lo(kv[c].y) + q[8 * c + 3] * bf_hi(kv[c].y)
                     + q[8 * c + 4] * bf_lo(kv[c].z) + q[8 * c + 5] * bf_hi(kv[c].z) + q[8 * c + 6] * bf_lo(kv[c].w) + q[8 * c + 7] * bf_hi(kv[c].w); }
            dot += __shfl_xor(dot, 1); dot += __shfl_xor(dot, 2);
            const float z2 = fminf(fmaxf(dot, -100.f), 100.f);
            const float e = __builtin_amdgcn_exp2f(-z2), beta = 1.f / (1.f + e), omb = e * beta;
            const bool valid = s < t;
            const float a = valid ? beta * R : 0.f; R = valid ? R * omb : R;
#pragma unroll
            for (int c = 0; c < 4; ++c) {
                o[8 * c + 0] += a * bf_lo(vv[c].x); o[8 * c + 1] += a * bf_hi(vv[c].x); o[8 * c + 2] += a * bf_lo(vv[c].y); o[8 * c + 3] += a * bf_hi(vv[c].y);
                o[8 * c + 4] += a * bf_lo(vv[c].z); o[8 * c + 5] += a * bf_hi(vv[c].z); o[8 * c + 6] += a * bf_lo(vv[c].w); o[8 * c + 7] += a * bf_hi(vv[c].w); }
        }
        GAS f32x4* op = (GAS f32x4*)(F.SBO + (size_t)(b * T + t) * 2048 + h * SBD + part * 32);
#pragma unroll
        for (int c = 0; c < 8; ++c) op[c] = (f32x4){o[4 * c], o[4 * c + 1], o[4 * c + 2], o[4 * c + 3]};
    }
}

__device__ __forceinline__ void ret_naive_phase(Frame& F) {
    const int gw = F.vcu * NWAVES + F.wave, NGW = F.G * NWAVES;
    const int lane = F.lane, ql = lane >> 4, part = lane & 15;
    for (int w = gw; w < 16 * 2048; w += NGW) {
        const int bh = w & 15; const int j = (w >> 4) / 128, g0 = (w >> 4) % 128;
        const int grp = (j & 1) ? 2047 - (g0 + 128 * (j - 1)) : g0 + 128 * j;
        const int b = bh >> 3, h = bh & 7, t0 = grp * 4, t = t0 + ql;
        const bf16* base = F.PROJ + (size_t)b * T * NIN + h * RD + part * 16;
        const float Lc = c_log2g[h] * 256.f;
        float q[16], o[16];
        { const GAS v4u* qp = (const GAS v4u*)(base + (size_t)t * NIN + C_RQ);
#pragma unroll
          for (int c = 0; c < 2; ++c) { const v4u v = qp[c];
              q[8 * c + 0] = bf_lo(v.x); q[8 * c + 1] = bf_hi(v.x); q[8 * c + 2] = bf_lo(v.y); q[8 * c + 3] = bf_hi(v.y);
              q[8 * c + 4] = bf_lo(v.z); q[8 * c + 5] = bf_hi(v.z); q[8 * c + 6] = bf_lo(v.w); q[8 * c + 7] = bf_hi(v.w); } }
#pragma unroll
        for (int i = 0; i < 16; ++i) o[i] = 0.f;
        const int ct = t >> 8;
        for (int s = t0 + 3; s >= 0; --s) {
            const GAS v4u* kp = (const GAS v4u*)(base + (size_t)s * NIN + C_RK);
            const GAS v4u* vp = (const GAS v4u*)(base + (size_t)s * NIN + C_RV);
            v4u kv[2], vv[2];
#pragma unroll
            for (int c = 0; c < 2; ++c) { kv[c] = kp[c]; vv[c] = vp[c]; }
            float dot = 0.f;
#pragma unroll
            for (int c = 0; c < 2; ++c) {
                dot += q[8 * c + 0] * bf_lo(kv[c].x) + q[8 * c + 1] * bf_hi(kv[c].x) + q[8 * c + 2] * bf_lo(kv[c].y) + q[8 * c + 3] * bf_hi(kv[c].y)
                     + q[8 * c + 4] * bf_lo(kv[c].z) + q[8 * c + 5] * bf_hi(kv[c].z) + q[8 * c + 6] * bf_lo(kv[c].w) + q[8 * c + 7] * bf_hi(kv[c].w); }
            dot += __shfl_xor(dot, 1); dot += __shfl_xor(dot, 2); dot += __shfl_xor(dot, 4); dot += __shfl_xor(dot, 8);
            const float cw = __builtin_amdgcn_exp2f(Lc * (float)(ct - (s >> 8)));
            const float a = (s <= t) ? dot * cw : 0.f;
#pragma unroll
            for (int c = 0; c < 2; ++c) {
                o[8 * c + 0] += a * bf_lo(vv[c].x); o[8 * c + 1] += a * bf_hi(vv[c].x); o[8 * c + 2] += a * bf_lo(vv[c].y); o[8 * c + 3] += a * bf_hi(vv[c].y);
                o[8 * c + 4] += a * bf_lo(vv[c].z); o[8 * c + 5] += a * bf_hi(vv[c].z); o[8 * c + 6] += a * bf_lo(vv[c].w); o[8 * c + 7] += a * bf_hi(vv[c].w); }
        }
        float s1 = 0.f;
#pragma unroll
        for (int i = 0; i < 16; ++i) s1 += o[i];
        s1 += __shfl_xor(s1, 1); s1 += __shfl_xor(s1, 2); s1 += __shfl_xor(s1, 4); s1 += __shfl_xor(s1, 8);
        const float mu = s1 * (1.f / 256.f); float s2 = 0.f;
#pragma unroll
        for (int i = 0; i < 16; ++i) { o[i] -= mu; s2 += o[i] * o[i]; }
        s2 += __shfl_xor(s2, 1); s2 += __shfl_xor(s2, 2); s2 += __shfl_xor(s2, 4); s2 += __shfl_xor(s2, 8);
        const float rstd = 1.0f / sqrtf(s2 * (1.f / 256.f) + EPS);
        const GAS v4u* gp = (const GAS v4u*)(base + (size_t)t * NIN + C_RG);
        const float* gn = F.g_ret + h * RD + part * 16;
        float gt[16];
#pragma unroll
        for (int c = 0; c < 2; ++c) { const v4u v = gp[c];
            gt[8 * c + 0] = bf_lo(v.x); gt[8 * c + 1] = bf_hi(v.x); gt[8 * c + 2] = bf_lo(v.y); gt[8 * c + 3] = bf_hi(v.y);
            gt[8 * c + 4] = bf_lo(v.z); gt[8 * c + 5] = bf_hi(v.z); gt[8 * c + 6] = bf_lo(v.w); gt[8 * c + 7] = bf_hi(v.w); }
        float y[16];
#pragma unroll
        for (int i = 0; i < 16; ++i) y[i] = o[i] * rstd * gn[i] * gt[i];
        GAS v4u* mp = (GAS v4u*)(F.MIX + (size_t)(b * T + t) * D + 2048 + h * RD + part * 16);
#pragma unroll
        for (int c = 0; c < 2; ++c) { v4u wv; wv.x = pk2(y[8 * c], y[8 * c + 1]); wv.y = pk2(y[8 * c + 2], y[8 * c + 3]); wv.z = pk2(y[8 * c + 4], y[8 * c + 5]); wv.w = pk2(y[8 * c + 6], y[8 * c + 7]); mp[c] = wv; }
    }
}


namespace sba {
using bf16x8 = __attribute__((ext_vector_type(8))) short;
using s16x4  = __attribute__((ext_vector_type(4))) short;
using f32x16 = __attribute__((ext_vector_type(16))) float;
using u32x4  = __attribute__((ext_vector_type(4))) unsigned;
constexpr int DH = 128, KVBLK = 64, LDK = NIN;
constexpr int SHM_V = KVBLK * DH * 2, SHM_K = KVBLK * DH * 2;
#define SBA_KSWZ(row, colB) ((row) * 256 + ((colB) ^ (((row) & 7) << 4)))
#define SBA_SBAR() __builtin_amdgcn_sched_barrier(0)
__device__ __forceinline__ int crow(int r, int hi) { return (r & 3) + 8 * (r >> 2) + 4 * hi; }
__device__ __forceinline__ unsigned cvtpk(float lo, float hi) { unsigned r; asm volatile("v_cvt_pk_bf16_f32 %0, %1, %2" : "=v"(r) : "v"(lo), "v"(hi)); return r; }
__device__ __forceinline__ void qkt(f32x16& p0, f32x16& p1, const char* Ks, const char* Qs, int r32, int hi) {
  p0 = f32x16{}; p1 = f32x16{};
#pragma unroll
  for (int d0 = 0; d0 < 8; ++d0) { const int cb = (d0 * 16 + hi * 8) * 2;
    const bf16x8 b0 = *reinterpret_cast<const bf16x8*>(Ks + SBA_KSWZ(r32, cb));
    const bf16x8 b1 = *reinterpret_cast<const bf16x8*>(Ks + SBA_KSWZ(32 + r32, cb));
    const bf16x8 q = *reinterpret_cast<const bf16x8*>(Qs + d0 * 1024);
    p0 = __builtin_amdgcn_mfma_f32_32x32x16_bf16(b0, q, p0, 0, 0, 0);
    p1 = __builtin_amdgcn_mfma_f32_32x32x16_bf16(b1, q, p1, 0, 0, 0); }
}
__device__ __forceinline__ int v_st(int k, int c) { const int kk = (k & ~0xC) | ((k & 4) << 1) | ((k & 8) >> 1); return ((kk >> 3) * 4 + (c >> 5)) * 512 + ((kk & 7) * 32 + (c & 31)) * 2; }
__device__ __forceinline__ int v_rd_base(int lane) { return ((lane & 3) << 3) | (((lane >> 2) & 3) << 6) | (((lane >> 4) & 1) << 5) | (((lane >> 5) & 1) << 8); }
constexpr int v_rd_off(int d0, int ks, int half) { return d0 * 512 + ks * 4096 + half * 2048; }
template <int OFF> __device__ __forceinline__ s16x4 tr_read(int vb) {
  s16x4 r; asm volatile("ds_read_b64_tr_b16 %0, %1 offset:%2" : "=&v"(r) : "v"(vb), "i"(OFF) : "memory"); return r;
}
template <int D0> __device__ __forceinline__ void pv_one(f32x16& od, int vb, bf16x8 pa0, bf16x8 pa1, bf16x8 pa2, bf16x8 pa3) {
  const s16x4 l0 = tr_read<v_rd_off(D0, 0, 0)>(vb), h0 = tr_read<v_rd_off(D0, 0, 1)>(vb), l1 = tr_read<v_rd_off(D0, 1, 0)>(vb), h1 = tr_read<v_rd_off(D0, 1, 1)>(vb);
  const s16x4 l2 = tr_read<v_rd_off(D0, 2, 0)>(vb), h2 = tr_read<v_rd_off(D0, 2, 1)>(vb), l3 = tr_read<v_rd_off(D0, 3, 0)>(vb), h3 = tr_read<v_rd_off(D0, 3, 1)>(vb);
  asm volatile("s_waitcnt lgkmcnt(0)" ::: "memory"); SBA_SBAR();
#define SBA_PK(L, H) (bf16x8){L[0], L[1], L[2], L[3], H[0], H[1], H[2], H[3]}
  od = __builtin_amdgcn_mfma_f32_32x32x16_bf16(pa0, SBA_PK(l0, h0), od, 0, 0, 0);
  od = __builtin_amdgcn_mfma_f32_32x32x16_bf16(pa1, SBA_PK(l1, h1), od, 0, 0, 0);
  od = __builtin_amdgcn_mfma_f32_32x32x16_bf16(pa2, SBA_PK(l2, h2), od, 0, 0, 0);
  od = __builtin_amdgcn_mfma_f32_32x32x16_bf16(pa3, SBA_PK(l3, h3), od, 0, 0, 0);
#undef SBA_PK
}
template <bool MASKED>
__device__ __forceinline__ void sb_weights(f32x16& p0, f32x16& p1, float& R, int hi, int lim) {
#pragma unroll
  for (int r = 0; r < 16; ++r) {
    const float e0 = __builtin_amdgcn_exp2f(-p0[r]), e1 = __builtin_amdgcn_exp2f(-p1[r]);
    float b0 = __builtin_amdgcn_rcpf(1.f + e0), b1 = __builtin_amdgcn_rcpf(1.f + e1);
    if (MASKED) { b0 = (crow(r, hi) < lim) ? b0 : 0.f; b1 = (32 + crow(r, hi) < lim) ? b1 : 0.f; }
    p0[r] = b0; p1[r] = b1;
  }
  float run = R;
#pragma unroll
  for (int G = 7; G >= 0; --G) {
    float gp;
    if (G < 4) gp = ((1.f - p0[4 * G]) * (1.f - p0[4 * G + 1])) * ((1.f - p0[4 * G + 2]) * (1.f - p0[4 * G + 3]));
    else       gp = ((1.f - p1[4 * G - 16]) * (1.f - p1[4 * G - 15])) * ((1.f - p1[4 * G - 14]) * (1.f - p1[4 * G - 13]));
    const auto rr = __builtin_amdgcn_permlane32_swap(__float_as_uint(gp), __float_as_uint(gp), false, false);
    const float glo = __uint_as_float(rr[0]), ghi = __uint_as_float(rr[1]);
    float t = run * (hi ? 1.f : ghi);
    if (G < 4) {
      const float a3 = p0[4 * G + 3] * t; t -= a3; const float a2 = p0[4 * G + 2] * t; t -= a2; const float a1 = p0[4 * G + 1] * t; t -= a1; const float a0 = p0[4 * G] * t;
      p0[4 * G] = a0; p0[4 * G + 1] = a1; p0[4 * G + 2] = a2; p0[4 * G + 3] = a3;
    } else {
      const int g = G - 4;
      const float a3 = p1[4 * g + 3] * t; t -= a3; const float a2 = p1[4 * g + 2] * t; t -= a2; const float a1 = p1[4 * g + 1] * t; t -= a1; const float a0 = p1[4 * g] * t;
      p1[4 * g] = a0; p1[4 * g + 1] = a1; p1[4 * g + 2] = a2; p1[4 * g + 3] = a3;
    }
    run *= glo * ghi;
  }
  R = run;
}
__device__ __forceinline__ void pack_p(const f32x16& p0, const f32x16& p1, bf16x8& pa0, bf16x8& pa1, bf16x8& pa2, bf16x8& pa3) {
#define SBA_PK4(P, BASE, OUT) do { unsigned a0 = cvtpk(P[BASE + 0], P[BASE + 1]), a1 = cvtpk(P[BASE + 2], P[BASE + 3]);   \
    unsigned b0 = cvtpk(P[BASE + 4], P[BASE + 5]), b1 = cvtpk(P[BASE + 6], P[BASE + 7]);                              \
    auto r0 = __builtin_amdgcn_permlane32_swap(a0, b0, false, false); auto r1 = __builtin_amdgcn_permlane32_swap(a1, b1, false, false); \
    u32x4 w = {r0[0], r1[0], r0[1], r1[1]}; OUT = *reinterpret_cast<bf16x8*>(&w); } while (0)
  SBA_PK4(p0, 0, pa0); SBA_PK4(p0, 8, pa1); SBA_PK4(p1, 0, pa2); SBA_PK4(p1, 8, pa3);
#undef SBA_PK4
}
__device__ __forceinline__ void unit(const bf16* __restrict__ Qh, const bf16* __restrict__ Kh, const bf16* __restrict__ Vh, float* __restrict__ Oh, int q0, char* lds) {
  const int tid = threadIdx.x, wid = tid >> 6, lane = tid & 63, r32 = lane & 31, hi = lane >> 5;
  char* V_lds = lds; char* K_lds = lds + 2 * SHM_V;
  volatile int* flags = (volatile int*)(lds + LDSCTL_OFF);
  char* Qs = lds + 2 * SHM_V + 2 * SHM_K + wid * 8192 + lane * 16;
  f32x16 o[4] = {};
  const int qrow0 = q0 + wid * 32;
  __syncthreads();
  { const bf16* Qw = Qh + (size_t)(qrow0 + r32) * LDK + hi * 8;
#pragma unroll
    for (int d0 = 0; d0 < 8; ++d0) *reinterpret_cast<bf16x8*>(Qs + d0 * 1024) = *reinterpret_cast<const bf16x8*>(Qw + d0 * 16); }
  const int sr = tid >> 4, sc = (tid & 15) * 8, vst0 = v_st(sr, sc), vst1 = v_st(32 + sr, sc);
  const int vb0 = (int)(uintptr_t)V_lds + v_rd_base(lane);
  bf16x8 vs0, vs1, ks0, ks1;
#define SBA_SLOAD(k0) do { vs0 = *reinterpret_cast<const bf16x8*>(&Vh[(size_t)((k0) + sr) * LDK + sc]); vs1 = *reinterpret_cast<const bf16x8*>(&Vh[(size_t)((k0) + 32 + sr) * LDK + sc]); \
    ks0 = *reinterpret_cast<const bf16x8*>(&Kh[(size_t)((k0) + sr) * LDK + sc]); ks1 = *reinterpret_cast<const bf16x8*>(&Kh[(size_t)((k0) + 32 + sr) * LDK + sc]); } while (0)
#define SBA_SWRITE(b) do { *(bf16x8*)(V_lds + (b) * SHM_V + vst0) = vs0; *(bf16x8*)(V_lds + (b) * SHM_V + vst1) = vs1; const int kc = sc * 2; \
    *(bf16x8*)(K_lds + (b) * SHM_K + SBA_KSWZ(sr, kc)) = ks0; *(bf16x8*)(K_lds + (b) * SHM_K + SBA_KSWZ(32 + sr, kc)) = ks1; } while (0)
  const int NT = (q0 + 256) / KVBLK;
  float R = 1.f;
  SBA_SLOAD((NT - 1) * KVBLK); asm volatile("s_waitcnt vmcnt(0)" ::: "memory"); SBA_SWRITE(0); __syncthreads();
  for (int j = 0; j < NT; ++j) {
    const int k0 = (NT - 1 - j) * KVBLK, buf = j & 1;
    if (j + 1 < NT) SBA_SLOAD(k0 - KVBLK);
    const int lim = qrow0 + r32 - k0;
    const bool live = __any(R != 0.f);
    if (k0 < qrow0 + 32 && live) {
      f32x16 p0, p1; bf16x8 pa0, pa1, pa2, pa3;
      qkt(p0, p1, K_lds + buf * SHM_K, Qs, r32, hi);
      if (k0 + KVBLK <= qrow0) sb_weights<false>(p0, p1, R, hi, lim); else sb_weights<true>(p0, p1, R, hi, lim);
      pack_p(p0, p1, pa0, pa1, pa2, pa3);
      const int vb = vb0 + buf * SHM_V;
      pv_one<0>(o[0], vb, pa0, pa1, pa2, pa3); pv_one<1>(o[1], vb, pa0, pa1, pa2, pa3); pv_one<2>(o[2], vb, pa0, pa1, pa2, pa3); pv_one<3>(o[3], vb, pa0, pa1, pa2, pa3);
    }
    { const int al = __any(R != 0.f) ? 1 : 0; if (lane == 0) flags[wid] = al; }
    if (j + 1 < NT) { asm volatile("s_waitcnt vmcnt(0)" ::: "memory"); SBA_SWRITE(buf ^ 1); }
    __syncthreads();
    int alive = 0;
#pragma unroll
    for (int w = 0; w < 8; ++w) alive |= flags[w];
    if (!alive) break;
    flags = (volatile int*)(lds + LDSCTL_OFF + ((j + 1) & 1) * 32);
  }
  float* Ow = Oh + (size_t)qrow0 * 2048;
#pragma unroll
  for (int r = 0; r < 16; ++r) { const int orow = crow(r, hi);
#pragma unroll
    for (int d0 = 0; d0 < 4; ++d0) Ow[(size_t)orow * 2048 + d0 * 32 + r32] = o[d0][r]; }
#undef SBA_SLOAD
#undef SBA_SWRITE
}
}

__device__ __forceinline__ void sb_fast_phase(Frame& F) {
  for (int p = blockIdx.x; p < 512; p += F.G) {
    const int bh = p >> 4, x = p & 15, b = bh >> 4, h = bh & 15;
    const bf16* base = F.PROJ + (size_t)b * T * NIN + h * SBD;
    float* Oh = F.SBO + (size_t)b * T * 2048 + h * SBD;
    sba::unit(base + C_SBQ, base + C_SBK, base + C_SBV, Oh, (31 - x) * 256, (char*)F.lds);
    sba::unit(base + C_SBQ, base + C_SBK, base + C_SBV, Oh, x * 256, (char*)F.lds);
  }
  __syncthreads();
}


namespace ret {
using sba::bf16x8; using sba::s16x4; using sba::f32x16; using sba::u32x4; using sba::crow; using sba::v_st; using sba::v_rd_base; using sba::v_rd_off; using sba::tr_read;
constexpr int IMG = 16384;
template <int D0, int KS> __device__ __forceinline__ bf16x8 tr_frag(int vb) {
  const s16x4 l = tr_read<v_rd_off(D0, KS, 0)>(vb), h = tr_read<v_rd_off(D0, KS, 1)>(vb);
  return (bf16x8){l[0], l[1], l[2], l[3], h[0], h[1], h[2], h[3]};
}
template <bool VST> __device__ __forceinline__ void stage_tile(const bf16* __restrict__ src, size_t pitch, char* dst, int tid) {
  const int sr = tid >> 4, sc = (tid & 15) * 8;
  bf16x8 v[4];
#pragma unroll
  for (int i = 0; i < 4; ++i) v[i] = *reinterpret_cast<const bf16x8*>(src + (size_t)(sr + 32 * (i & 1)) * pitch + (i >> 1) * 128 + sc);
#pragma unroll
  for (int i = 0; i < 4; ++i) { const int row = sr + 32 * (i & 1); const int off = VST ? v_st(row, sc) : SBA_KSWZ(row, sc * 2);
    *reinterpret_cast<bf16x8*>(dst + (i >> 1) * IMG + off) = v[i]; }
}
template <int KS> __device__ __forceinline__ void passA_step(f32x16 (&acc)[2][4], int vbV, int vbK) {
  const bf16x8 a0 = tr_frag<0, KS>(vbV), a1 = tr_frag<1, KS>(vbV);
  const bf16x8 b0 = tr_frag<0, KS>(vbK), b1 = tr_frag<1, KS>(vbK), b2 = tr_frag<2, KS>(vbK), b3 = tr_frag<3, KS>(vbK);
  asm volatile("s_waitcnt lgkmcnt(0)" ::: "memory"); SBA_SBAR();
  acc[0][0] = __builtin_amdgcn_mfma_f32_32x32x16_bf16(a0, b0, acc[0][0], 0, 0, 0); acc[0][1] = __builtin_amdgcn_mfma_f32_32x32x16_bf16(a0, b1, acc[0][1], 0, 0, 0);
  acc[0][2] = __builtin_amdgcn_mfma_f32_32x32x16_bf16(a0, b2, acc[0][2], 0, 0, 0); acc[0][3] = __builtin_amdgcn_mfma_f32_32x32x16_bf16(a0, b3, acc[0][3], 0, 0, 0);
  acc[1][0] = __builtin_amdgcn_mfma_f32_32x32x16_bf16(a1, b0, acc[1][0], 0, 0, 0); acc[1][1] = __builtin_amdgcn_mfma_f32_32x32x16_bf16(a1, b1, acc[1][1], 0, 0, 0);
  acc[1][2] = __builtin_amdgcn_mfma_f32_32x32x16_bf16(a1, b2, acc[1][2], 0, 0, 0); acc[1][3] = __builtin_amdgcn_mfma_f32_32x32x16_bf16(a1, b3, acc[1][3], 0, 0, 0);
}
__device__ __forceinline__ void unitA(const bf16* __restrict__ Kc, const bf16* __restrict__ Vc, float* __restrict__ UT, char* lds) {
  const int tid = threadIdx.x, wid = tid >> 6, lane = tid & 63, r32 = lane & 31, hi = lane >> 5, wr = wid >> 1, wc = wid & 1;
  f32x16 acc[2][4] = {};
  const int vbase = (int)(uintptr_t)lds + v_rd_base(lane);
  const int vbK = vbase + wc * IMG;
  const int vbV = vbase + 2 * IMG + (wr >> 1) * IMG + (wr & 1) * 1024;
  for (int tt = 0; tt < 4; ++tt) {
    __syncthreads();
    stage_tile<true>(Kc + (size_t)tt * 64 * NIN, NIN, lds, tid);
    stage_tile<true>(Vc + (size_t)tt * 64 * NIN, NIN, lds + 2 * IMG, tid);
    __syncthreads();
    passA_step<0>(acc, vbV, vbK); passA_step<1>(acc, vbV, vbK); passA_step<2>(acc, vbV, vbK); passA_step<3>(acc, vbV, vbK);
  }
#pragma unroll
  for (int a = 0; a < 2; ++a)
#pragma unroll
    for (int bb = 0; bb < 4; ++bb)
#pragma unroll
      for (int r = 0; r < 16; ++r) UT[(size_t)(64 * wr + 32 * a + crow(r, hi)) * 256 + 128 * wc + 32 * bb + r32] = acc[a][bb][r];
}
constexpr int KP = 528, KPAD_BYTES = 64 * KP;
__device__ __forceinline__ void stage_rows(const bf16* __restrict__ src, size_t pitch, char* dst, int tid) {
  const int sr = tid >> 5, sc = (tid & 31) * 8;
  bf16x8 v[4];
#pragma unroll
  for (int i = 0; i < 4; ++i) v[i] = *reinterpret_cast<const bf16x8*>(src + (size_t)(sr + 16 * i) * pitch + sc);
#pragma unroll
  for (int i = 0; i < 4; ++i) *reinterpret_cast<bf16x8*>(dst + (sr + 16 * i) * KP + sc * 2) = v[i];
}
__device__ __forceinline__ void qkt256(f32x16& p0, f32x16& p1, const char* Kl, const char* Qs) {
  p0 = f32x16{}; p1 = f32x16{};
#pragma unroll
  for (int ks = 0; ks < 16; ++ks) {
    const bf16x8 b0 = *reinterpret_cast<const bf16x8*>(Kl + ks * 32);
    const bf16x8 b1 = *reinterpret_cast<const bf16x8*>(Kl + 32 * KP + ks * 32);
    const bf16x8 q = *reinterpret_cast<const bf16x8*>(Qs + ks * 1024);
    p0 = __builtin_amdgcn_mfma_f32_32x32x16_bf16(b0, q, p0, 0, 0, 0);
    p1 = __builtin_amdgcn_mfma_f32_32x32x16_bf16(b1, q, p1, 0, 0, 0); }
}
template <int I> __device__ __forceinline__ void cross_piece(f32x16& oi, const bf16* __restrict__ ST, char* lds, const char* Sl, const char* Qs, int tid) {
  __syncthreads();
  stage_rows(ST + (size_t)(64 * I) * 256, 256, lds + 98304, tid);
  __syncthreads();
#pragma unroll
  for (int ks = 0; ks < 16; ++ks) {
    const bf16x8 bfr = *reinterpret_cast<const bf16x8*>(Sl + ks * 32);
    const bf16x8 q = *reinterpret_cast<const bf16x8*>(Qs + ks * 1024);
    oi = __builtin_amdgcn_mfma_f32_32x32x16_bf16(q, bfr, oi, 0, 0, 0); }
}
__device__ __forceinline__ void unitC(const bf16* __restrict__ Qc, const bf16* __restrict__ Kc, const bf16* __restrict__ Vc, const bf16* __restrict__ Gc, const bf16* __restrict__ ST, bool has_state,
                                      const float* __restrict__ gn, bf16* __restrict__ Mc, int r0, char* lds) {
  const int tid = threadIdx.x, wid = tid >> 6, lane = tid & 63, r32 = lane & 31, hi = lane >> 5, rg = wid & 3, dh = wid >> 2;
  f32x16 o[4] = {};
  const int qrow0 = r0 + 32 * rg;
  char* Qs = lds + rg * 16384 + lane * 16;
  const char* Kl = lds + 98304 + r32 * KP + hi * 16;
  const char* Sl = lds + 98304 + (dh * 32 + r32) * KP + hi * 16;
  __syncthreads();
  { const bf16* Qw = Qc + (size_t)(qrow0 + r32) * NIN + hi * 8;
#pragma unroll
    for (int k8 = 0; k8 < 8; ++k8) { const int ks = dh * 8 + k8; *reinterpret_cast<bf16x8*>(Qs + ks * 1024) = *reinterpret_cast<const bf16x8*>(Qw + ks * 16); } }
  if (has_state) {
    cross_piece<0>(o[0], ST, lds, Sl, Qs, tid); cross_piece<1>(o[1], ST, lds, Sl, Qs, tid); cross_piece<2>(o[2], ST, lds, Sl, Qs, tid); cross_piece<3>(o[3], ST, lds, Sl, Qs, tid);
  }
  const int ntile = (r0 + 128) / 64;
  const int vb0 = (int)(uintptr_t)lds + 65536 + v_rd_base(lane) + dh * 512;
  for (int kt = 0; kt < ntile; ++kt) {
    const int k0 = kt * 64;
    __syncthreads();
    stage_rows(Kc + (size_t)k0 * NIN, NIN, lds + 98304, tid);
    stage_tile<true>(Vc + (size_t)k0 * NIN, NIN, lds + 65536, tid);
    __syncthreads();
    if (k0 <= qrow0 + 31) {
      f32x16 p0, p1; bf16x8 pa0, pa1, pa2, pa3;
      qkt256(p0, p1, Kl, Qs);
      if (k0 + 63 > qrow0) {
        const int lim = qrow0 + r32 - k0 + 1;
#pragma unroll
        for (int r = 0; r < 16; ++r) { p0[r] = (crow(r, hi) < lim) ? p0[r] : 0.f; p1[r] = (32 + crow(r, hi) < lim) ? p1[r] : 0.f; }
      }
      sba::pack_p(p0, p1, pa0, pa1, pa2, pa3);
      sba::pv_one<0>(o[0], vb0, pa0, pa1, pa2, pa3); sba::pv_one<2>(o[1], vb0, pa0, pa1, pa2, pa3);
      sba::pv_one<0>(o[2], vb0 + IMG, pa0, pa1, pa2, pa3); sba::pv_one<2>(o[3], vb0 + IMG, pa0, pa1, pa2, pa3);
    }
  }
  __syncthreads();
  float* Ol = (float*)lds;
#pragma unroll
  for (int i = 0; i < 4; ++i)
#pragma unroll
    for (int r = 0; r < 16; ++r) Ol[(32 * rg + crow(r, hi)) * 256 + (2 * i + dh) * 32 + r32] = o[i][r];
  __syncthreads();
  int le = lane; asm volatile("" : "+v"(le));
  const f32x4 gg = *(const f32x4*)(gn + le * 4);
  for (int rr = 0; rr < 16; ++rr) {
    const int row = wid * 16 + rr;
    const f32x4 v = *(const f32x4*)(Ol + row * 256 + le * 4);
    const float mu = wave_sum((v.x + v.y) + (v.z + v.w)) * (1.f / 256.f);
    const f32x4 d = v - mu;
    const float var = wave_sum((d.x * d.x + d.y * d.y) + (d.z * d.z + d.w * d.w)) * (1.f / 256.f);
    const float rstd = 1.0f / sqrtf(var + EPS);
    const v2u gw = *(const v2u*)(Gc + (size_t)(r0 + row) * NIN + le * 4);
    const f32x4 y = d * rstd * gg * (f32x4){bf_lo(gw.x), bf_hi(gw.x), bf_lo(gw.y), bf_hi(gw.y)};
    v2u ow; ow.x = pk2(y.x, y.y); ow.y = pk2(y.z, y.w);
    *(v2u*)(Mc + (size_t)(r0 + row) * D + le * 4) = ow;
  }
}
}

__device__ __forceinline__ void ret_passA_phase(Frame& F) {
  for (int u = blockIdx.x; u < 16 * 32; u += F.G) {
    const int bh = u >> 5, c = u & 31, b = bh >> 3, h = bh & 7;
    const bf16* base = F.PROJ + ((size_t)b * T + (size_t)c * 256) * NIN + h * RD;
    ret::unitA(base + C_RK, base + C_RV, F.UT + (size_t)u * 65536, (char*)F.lds);
  }
  __syncthreads();
}
__device__ __forceinline__ void ret_scan_phase(Frame& F) {
  const int gt = (F.vcu * NWAVES + F.wave) * 64 + F.lane, NT_ = F.G * NWAVES * 64;
  for (int e = gt; e < 16 * 16384; e += NT_) {
    const int bh = e >> 14, q = e & 16383, h = bh & 7;
    const float gC = __builtin_amdgcn_exp2f(c_log2g[h] * 256.f);
    const float* up = F.UT + (size_t)bh * 32 * 65536 + q * 4;
    bf16* sp = F.ST + (size_t)bh * 32 * 65536 + q * 4;
    f32x4 s = (f32x4){0.f, 0.f, 0.f, 0.f};
#pragma unroll 8
    for (int c = 0; c < 32; ++c) {
      v2u w; w.x = pk2(s.x, s.y); w.y = pk2(s.z, s.w);
      *(GAS v2u*)(sp + (size_t)c * 65536) = w;
      const f32x4 u = *(const GAS f32x4*)(up + (size_t)c * 65536);
      s = (s + u) * gC;
    }
  }
}
__device__ __forceinline__ void ret_passC_phase(Frame& F) {
  for (int u = blockIdx.x; u < 16 * 32; u += F.G) {
    const int bh = u >> 5, c = u & 31, b = bh >> 3, h = bh & 7;
    const size_t tok0 = (size_t)b * T + (size_t)c * 256;
    const bf16* base = F.PROJ + tok0 * NIN + h * RD;
    const bf16* ST = F.ST + (size_t)u * 65536;
    bf16* Mc = F.MIX + tok0 * D + 2048 + h * RD;
    ret::unitC(base + C_RQ, base + C_RK, base + C_RV, base + C_RG, ST, c != 0, F.g_ret + h * RD, Mc, 0, (char*)F.lds);
    ret::unitC(base + C_RQ, base + C_RK, base + C_RV, base + C_RG, ST, c != 0, F.g_ret + h * RD, Mc, 128, (char*)F.lds);
  }
  __syncthreads();
}

struct Args { const float* in[10]; float* out; unsigned char* ws; int ph_lo, ph_hi, li, pad; };
__global__ void __launch_bounds__(NWAVES * 64, 2) hymba_fwd(Args args) {
    extern __shared__ __attribute__((aligned(16))) unsigned char lds[];
    Frame F;
    F.lds = (LAS unsigned char*)lds;
    F.MISC = (volatile LAS unsigned*)(F.lds + MISC_OFF);
    F.tid = threadIdx.x; F.lane = F.tid & 63; F.wave = __builtin_amdgcn_readfirstlane(F.tid >> 6);
    F.G = gridDim.x; { const int bx = blockIdx.x; F.vcu = (F.G % 8 == 0) ? (bx % 8) * (F.G / 8) + bx / 8 : bx; }
    unsigned char* ws = args.ws;
    F.ctl = (gu32*)(ws + WS_CTL);
    F.x = args.in[0]; F.g_attn = args.in[1]; F.w_in = args.in[2]; F.g_sb = args.in[3]; F.g_ret = args.in[4]; F.w_out = args.in[5];
    F.g_mlp = args.in[6]; F.w_up = args.in[7]; F.w_down = args.in[8]; F.g_fin = args.in[9]; F.out = args.out;
    F.XN = (bf16*)(ws + WS_XN); F.WIN = (bf16*)(ws + WS_WIN); F.WOUT = (bf16*)(ws + WS_WOUT); F.PROJ = (bf16*)(ws + WS_PROJ); F.MIX = (bf16*)(ws + WS_MIX);
    F.WUP = (bf16*)(ws + WS_WUP); F.HID = (bf16*)(ws + WS_HID); F.WDOWN = (bf16*)(ws + WS_WDOWN);
    F.SBO = (float*)(ws + WS_XN); F.ROPE = (float*)(ws + WS_ROPE); F.UT = (float*)(ws + WS_XN); F.ST = (bf16*)(ws + WS_STATE);
    for (int u = F.tid; u < (LDS_BYTES - LDSCTL_OFF) / 4; u += NWAVES * 64) ((LAS unsigned*)(F.lds + LDSCTL_OFF))[u] = 0u;
    __syncthreads();
    XcdBarrier bar; bar.bar = (unsigned*)(F.ctl + CW_BAR); bar.x = 0; bar.st = nullptr;
    if (N_LAUNCHES != PER_PHASE) bar = xcd_barrier_post((unsigned*)(F.ctl + CW_BAR) + args.li * XCD_BAR_WORDS, F.MISC + 8);
#define GRID_BAR(seam) do { if (N_LAUNCHES == PER_PHASE) { if (F.tid == 0) __hip_atomic_store(F.ctl + CW_TMO, 0xBADBA0u | (unsigned)(seam), RLX_AGENT); } \
    else { xcd_barrier(bar); } } while (0)
    const int lo = args.ph_lo, hi = args.ph_hi;
#define IN(k) (lo <= (k) && (k) < hi)
#define BOTH(k) (IN(k) && IN((k) + 1))
    const int gw = F.vcu * NWAVES + F.wave, NGW = F.G * NWAVES;

    if (IN(0)) { p0_prologue(F); if (BOTH(0)) GRID_BAR(0); }
    if (IN(1)) {
        pg8::Gemm g{F.XN, F.WIN, M, NIN, D}; pg8::StaticOrder S; S.init(M, NIN, F.G, (int)blockIdx.x);
        EpiProj E{F.PROJ, F.ROPE};
        pg8::gemm_phase<EpiProj, pg8::StaticOrder, true, true>(F.lds + RING_OFF, g, S, E);
        if (BOTH(1)) GRID_BAR(1);
    }
    if (IN(2)) { ret_passA_phase(F); if (BOTH(2)) GRID_BAR(2); }
    if (IN(3)) { ret_scan_phase(F); if (BOTH(3)) GRID_BAR(3); }
    if (IN(4)) { sb_fast_phase(F); ret_passC_phase(F); if (BOTH(4)) GRID_BAR(4); }
    if (IN(5)) {
        for (int m = gw; m < M; m += NGW) rms_row<8, true>(F.SBO + (size_t)m * 2048, F.g_sb, F.MIX + (size_t)m * D, F.lane);
        if (BOTH(5)) GRID_BAR(5);
    }
    if (IN(6)) {
        pg8::Gemm g{F.MIX, F.WOUT, M, D, D}; pg8::StaticOrder S; S.init(M, D, F.G, (int)blockIdx.x);
        EpiResF32 E{F.x, F.out, D};
        pg8::gemm_phase<EpiResF32, pg8::StaticOrder, true, true>(F.lds + RING_OFF, g, S, E);
        if (BOTH(6)) GRID_BAR(6);
    }
    if (IN(7)) {
        for (int m = gw; m < M; m += NGW) rms_row<16, true>(F.out + (size_t)m * D, F.g_mlp, F.XN + (size_t)m * D, F.lane);
        transpose_matrix(F, F.w_up, D, FF, F.WUP);
        transpose_matrix(F, F.w_down, FF, D, F.WDOWN);
        if (BOTH(7)) GRID_BAR(7);
    }
    if (IN(8)) {
        pg8::Gemm g{F.XN, F.WUP, M, FF, D}; pg8::StaticOrder S; S.init(M, FF, F.G, (int)blockIdx.x);
        EpiRelu2 E{F.HID, FF};
        pg8::gemm_phase<EpiRelu2, pg8::StaticOrder, true, true>(F.lds + RING_OFF, g, S, E);
        if (BOTH(8)) GRID_BAR(8);
    }
    if (IN(9)) {
        pg8::Gemm g{F.HID, F.WDOWN, M, D, FF}; pg8::StaticOrder S; S.init(M, D, F.G, (int)blockIdx.x);
        EpiResF32 E{F.out, F.out, D};
        pg8::gemm_phase<EpiResF32, pg8::StaticOrder, true, true>(F.lds + RING_OFF, g, S, E);
        if (BOTH(9)) GRID_BAR(9);
    }
    if (IN(10)) {
        for (int m = gw; m < M; m += NGW) rms_row<16, false>(F.out + (size_t)m * D, F.g_fin, F.out + (size_t)m * D, F.lane);
    }
#undef IN
#undef BOTH
}

extern "C" void kernel_launch(void* const* d_in, const int* in_sizes, int n_in, void* d_out, int out_size, void* d_ws, size_t ws_size, hipStream_t stream) {
    static int grid = 0;
    if (grid == 0) {
        if (n_in != 10 || in_sizes[0] != M * D || out_size != M * D || ws_size < WS_END) { fprintf(stderr, "kernel_launch: shape/workspace mismatch (ws %zu, need %zu)\n", ws_size, (size_t)WS_END); grid = -1; return; }
        int dev = 0, cus = 0, per_cu = 0;
        if (hipGetDevice(&dev) != hipSuccess || hipDeviceGetAttribute(&cus, hipDeviceAttributeMultiprocessorCount, dev) != hipSuccess) { grid = -1; return; }
        if (hipFuncSetAttribute((const void*)hymba_fwd, hipFuncAttributeMaxDynamicSharedMemorySize, LDS_BYTES) != hipSuccess) { fprintf(stderr, "kernel_launch: hipFuncSetAttribute failed\n"); grid = -1; return; }
        if (hipOccupancyMaxActiveBlocksPerMultiprocessor(&per_cu, (const void*)hymba_fwd, NWAVES * 64, LDS_BYTES) != hipSuccess || per_cu < 1)
            fprintf(stderr, "kernel_launch: occupancy query reports %d workgroups per CU\n", per_cu);
        (void)hipGetLastError();
        grid = cus;
    }
    if (grid < 0) return;
    if (hipMemsetAsync((char*)d_ws + WS_CTL, 0, CTL_ZERO_BYTES, stream) != hipSuccess) return;
    Args a{};
    for (int i = 0; i < 10; ++i) a.in[i] = (const float*)d_in[i];
    a.out = (float*)d_out; a.ws = (unsigned char*)d_ws;
    if (N_LAUNCHES == 1) {
        a.ph_lo = 0; a.ph_hi = PER_PHASE; a.li = 0;
        hipLaunchKernelGGL(hymba_fwd, dim3(grid), dim3(NWAVES * 64), LDS_BYTES, stream, a);
    } else {
        for (int li = 0; li < PER_PHASE; ++li) {
            a.ph_lo = li; a.ph_hi = li + 1; a.li = 0;
            hipLaunchKernelGGL(hymba_fwd, dim3(grid), dim3(NWAVES * 64), LDS_BYTES, stream, a);
        }
    }
    const hipError_t le = hipPeekAtLastError();
    if (le != hipSuccess) fprintf(stderr, "kernel_launch: launch failed: %s\n", hipGetErrorName(le));
}
```

```cpp
#include <hip/hip_runtime.h>
#include <cstdio>
#include <cstdint>

namespace pg8 {
#define PG8_LAS __attribute__((address_space(3)))
typedef unsigned short bf16_t;
typedef short bf16x8 __attribute__((ext_vector_type(8)));
typedef float f32x4 __attribute__((ext_vector_type(4)));
typedef unsigned u32x4 __attribute__((ext_vector_type(4)));
constexpr int BM = 256, BK = 64, HALF = 128, HTB = HALF * BK * 2, STAGE_BYTES = 8 * HTB, NXCD = 8, WGM = 8;

__host__ __device__ __forceinline__ int lds_byte(int r, int c) { const int st = (r >> 4) * 2 + (c >> 5), rr = r & 15, cc = c & 31, ob = rr * 64 + cc * 2; return st * 1024 + (ob ^ (((ob >> 9) & 1) << 5)); }
__host__ __device__ __forceinline__ void stage_rc(int b, int& R, int& C) { const int st = b / 1024, sb = b % 1024, swz = sb ^ (((sb >> 9) & 1) << 5); R = (st >> 1) * 16 + swz / 64; C = (st & 1) * 32 + (swz % 64) / 2; }
__host__ __device__ __forceinline__ int perm32(int rho) { const int n = rho >> 4, i = rho & 15; return 8 * (i >> 2) + 4 * n + (i & 3); }

struct Unit { int pm, pn; };
struct Gemm { const bf16_t* A; const bf16_t* Bt; int M, N, K; };

struct StaticOrder {
    int nM, nN, nwg, G, c, wgm;
    __host__ __device__ void init(int M, int N, int G_, int c_, int wgm_ = WGM) { nM = M / BM; nN = N / BM; nwg = nM * nN; G = G_; c = c_; wgm = wgm_; }
    __host__ __device__ bool next(int i, Unit& u) const {
        const long L = (long)i * G + c; if (L >= nwg) return false;
        int wgid = (int)L; { const int q = nwg / NXCD, r = nwg % NXCD, xcd = wgid % NXCD, off = wgid / NXCD; wgid = (xcd < r ? xcd * (q + 1) : r * (q + 1) + (xcd - r) * q) + off; }
        const int nig = wgm * nN, gid = wgid / nig, fm = gid * wgm, gsz = (nM - fm) < wgm ? (nM - fm) : wgm;
        u.pm = fm + ((wgid % nig) % gsz); u.pn = (wgid % nig) / gsz; return true;
    }
    __device__ __forceinline__ void a_ready(const Unit&) const {}
    __device__ __forceinline__ void done(const Unit&) const {}
};

__device__ __forceinline__ unsigned cvt_pk_bf16(float lo, float hi) { unsigned r; asm volatile("v_cvt_pk_bf16_f32 %0, %1, %2" : "=v"(r) : "v"(lo), "v"(hi)); return r; }

struct NoKHook { static constexpr bool ACTIVE = false; __device__ __forceinline__ void operator()(int, f32x4 (&)[2][2][4][2], int, int) const {} };
template <class Epi, class Sched, bool ALIGN_EPI = false, bool SP2 = false, class KHook = NoKHook>
__device__ __forceinline__ void gemm_phase(PG8_LAS unsigned char* lds, const Gemm g, const Sched& S, const Epi& E, const KHook& KH = KHook()) {
    const int tid = threadIdx.x, wid = __builtin_amdgcn_readfirstlane(tid >> 6), lane = tid & 63, wr = wid >> 2, wc = wid & 3, fr = lane & 15, fq = lane >> 4;
    const int K = g.K, nt = K / BK;
    unsigned voffA[2], voffB[2];
#pragma unroll
    for (int i = 0; i < 2; ++i) { int R, C; stage_rc(tid * 16 + i * 8192, R, C); const int Rb = Epi::PERM ? ((R & ~31) + perm32(R & 31)) : R;
        voffA[i] = (unsigned)(R * K + C) * 2u; voffB[i] = (unsigned)(Rb * K + C) * 2u; }
    const size_t kstep = (size_t)(BK * 2);
    const size_t hstep = (size_t)HALF * K * 2;
    const size_t tstep = 2 * hstep;
    const unsigned ldsw = (unsigned)wid * 1024u;
    const int aoff = lds_byte(wr * 64 + fr, fq * 8), boff = lds_byte(wc * 32 + fr, fq * 8);
#define PG8_SA(b, h) (((b) * 2 + (h)) * HTB)
#define PG8_SB(b, h) ((4 + (b) * 2 + (h)) * HTB)
#define PG8_STAGE(bufoff, gbase, voff) do { _Pragma("unroll") for (int _i = 0; _i < 2; ++_i) \
        __builtin_amdgcn_global_load_lds((const unsigned*)((const char*)(gbase) + (voff)[_i]), (PG8_LAS unsigned*)(lds + (bufoff) + ldsw + _i * 8192), 16, 0, 0); } while (0)
#define PG8_LDA(dst, b, h) do { _Pragma("unroll") for (int m = 0; m < 4; ++m) _Pragma("unroll") for (int k = 0; k < 2; ++k) dst[m][k] = *(const PG8_LAS bf16x8*)(lds + PG8_SA(b, h) + aoff + m * 2048 + k * 1024); } while (0)
#define PG8_LDB(dst, b, h) do { _Pragma("unroll") for (int n = 0; n < 2; ++n) _Pragma("unroll") for (int k = 0; k < 2; ++k) dst[n][k] = *(const PG8_LAS bf16x8*)(lds + PG8_SB(b, h) + boff + n * 2048 + k * 1024); } while (0)
#define PG8_MMA(ai, bj, At, Bt) do { __builtin_amdgcn_s_setprio(1); _Pragma("unroll") for (int m = 0; m < 4; ++m) _Pragma("unroll") for (int n = 0; n < 2; ++n) _Pragma("unroll") for (int k = 0; k < 2; ++k) \
        acc[ai][bj][m][n] = __builtin_amdgcn_mfma_f32_16x16x32_bf16(Bt[n][k], At[m][k], acc[ai][bj][m][n], 0, 0, 0); __builtin_amdgcn_s_setprio(0); } while (0)
#define PG8_WAIT_V(n) asm volatile("s_waitcnt vmcnt(" #n ")" ::: "memory")
#define PG8_WAIT_L(n) asm volatile("s_waitcnt lgkmcnt(" #n ")" ::: "memory")
#define PG8_BAR __builtin_amdgcn_s_barrier()
#define PG8_SCHED __builtin_amdgcn_sched_barrier(0)
    Unit cur, nxt; int ui = 0;
    if (!S.next(0, cur)) return;
    f32x4 acc[2][2][4][2];
#pragma unroll
    for (int a = 0; a < 2; ++a)
#pragma unroll
        for (int b = 0; b < 2; ++b)
#pragma unroll
            for (int m = 0; m < 4; ++m)
#pragma unroll
                for (int n = 0; n < 2; ++n) acc[a][b][m][n] = (f32x4){0.f, 0.f, 0.f, 0.f};
    bf16x8 At[4][2], B0[2][2], B1[2][2];
    const char* cA = (const char*)g.A + (size_t)cur.pm * tstep; const char* cB = (const char*)g.Bt + (size_t)cur.pn * tstep;
    S.a_ready(cur);
    if constexpr (SP2) {
        PG8_STAGE(PG8_SB(0, 0), cB, voffB); PG8_STAGE(PG8_SB(0, 1), cB + hstep, voffB); PG8_STAGE(PG8_SA(0, 0), cA, voffA); PG8_STAGE(PG8_SA(0, 1), cA + hstep, voffA);
        if (wr == 1) PG8_BAR;
        PG8_WAIT_V(2); PG8_BAR;
        PG8_STAGE(PG8_SB(1, 0), cB + kstep, voffB); PG8_STAGE(PG8_SA(1, 0), cA + kstep, voffA); PG8_STAGE(PG8_SB(1, 1), cB + hstep + kstep, voffB);
        PG8_WAIT_V(6); PG8_BAR;
    } else {
        PG8_STAGE(PG8_SB(0, 0), cB, voffB); PG8_STAGE(PG8_SA(0, 0), cA, voffA); PG8_STAGE(PG8_SB(0, 1), cB + hstep, voffB); PG8_STAGE(PG8_SA(0, 1), cA + hstep, voffA);
        if (wr == 1) PG8_BAR;
        PG8_WAIT_V(4); PG8_BAR;
        PG8_STAGE(PG8_SB(1, 0), cB + kstep, voffB); PG8_STAGE(PG8_SA(1, 0), cA + kstep, voffA); PG8_STAGE(PG8_SB(1, 1), cB + hstep + kstep, voffB);
        PG8_WAIT_V(6); PG8_BAR;
    }
    for (;;) {
        const bool has_next = S.next(ui + 1, nxt);
        const char* nA = has_next ? (const char*)g.A + (size_t)nxt.pm * tstep : cA; const char* nB = has_next ? (const char*)g.Bt + (size_t)nxt.pn * tstep : cB;
        for (int t = 0; t < nt; t += 2) {
            const bool last = (t == nt - 2);
            const char* a1 = cA + (size_t)(t + 1) * kstep;
            const char* a2 = last ? nA : cA + (size_t)(t + 2) * kstep; const char* b2 = last ? nB : cB + (size_t)(t + 2) * kstep;
            const char* a3 = a2 + kstep; const char* b3 = b2 + kstep;
            if (last && has_next) S.a_ready(nxt);
            if constexpr (KHook::ACTIVE) KH(t, acc, wr, fr);
            if constexpr (SP2) {
            PG8_LDB(B0, 0, 0); PG8_LDB(B1, 0, 1); PG8_SCHED; PG8_LDA(At, 0, 0); PG8_STAGE(PG8_SA(1, 1), a1 + hstep, voffA);
            PG8_WAIT_V(8); PG8_WAIT_L(0); PG8_BAR; PG8_MMA(0, 0, At, B0); PG8_MMA(0, 1, At, B1); PG8_BAR; PG8_SCHED;
            PG8_LDA(At, 0, 1); PG8_STAGE(PG8_SB(0, 0), b2, voffB); PG8_STAGE(PG8_SB(0, 1), b2 + hstep, voffB); PG8_STAGE(PG8_SA(0, 0), a2, voffA);
            PG8_WAIT_V(8); PG8_WAIT_L(0); PG8_BAR; PG8_MMA(1, 0, At, B0); PG8_MMA(1, 1, At, B1); PG8_BAR; PG8_SCHED;
            PG8_LDB(B0, 1, 0); PG8_LDB(B1, 1, 1); PG8_SCHED; PG8_LDA(At, 1, 0); PG8_STAGE(PG8_SA(0, 1), a2 + hstep, voffA);
            PG8_WAIT_V(8); PG8_WAIT_L(0); PG8_BAR; PG8_MMA(0, 0, At, B0); PG8_MMA(0, 1, At, B1); PG8_BAR; PG8_SCHED;
            PG8_LDA(At, 1, 1); PG8_STAGE(PG8_SB(1, 0), b3, voffB); PG8_STAGE(PG8_SB(1, 1), b3 + hstep, voffB); PG8_STAGE(PG8_SA(1, 0), a3, voffA);
            PG8_WAIT_V(8); PG8_WAIT_L(0); PG8_BAR; PG8_MMA(1, 0, At, B0); PG8_MMA(1, 1, At, B1); PG8_BAR; PG8_SCHED;
            } else {
            PG8_LDB(B0, 0, 0); PG8_SCHED; PG8_LDA(At, 0, 0); PG8_STAGE(PG8_SA(1, 1), a1 + hstep, voffA);
            PG8_WAIT_L(8); PG8_BAR; PG8_WAIT_L(0); PG8_MMA(0, 0, At, B0); PG8_BAR; PG8_SCHED;
            PG8_LDB(B1, 0, 1); PG8_STAGE(PG8_SB(0, 0), b2, voffB);
            PG8_BAR; PG8_WAIT_L(0); PG8_MMA(0, 1, At, B1); PG8_BAR;
            PG8_LDA(At, 0, 1); PG8_STAGE(PG8_SA(0, 0), a2, voffA);
            PG8_BAR; PG8_WAIT_L(0); PG8_MMA(1, 0, At, B0); PG8_BAR; PG8_SCHED;
            PG8_STAGE(PG8_SB(0, 1), b2 + hstep, voffB);
            PG8_WAIT_V(6); PG8_BAR; PG8_MMA(1, 1, At, B1); PG8_BAR;
            PG8_LDB(B0, 1, 0); PG8_SCHED; PG8_LDA(At, 1, 0); PG8_STAGE(PG8_SA(0, 1), a2 + hstep, voffA);
            PG8_WAIT_L(8); PG8_BAR; PG8_WAIT_L(0); PG8_MMA(0, 0, At, B0); PG8_BAR; PG8_SCHED;
            PG8_LDB(B1, 1, 1); PG8_STAGE(PG8_SB(1, 0), b3, voffB);
            PG8_BAR; PG8_WAIT_L(0); PG8_MMA(0, 1, At, B1); PG8_BAR;
            PG8_LDA(At, 1, 1); PG8_STAGE(PG8_SA(1, 0), a3, voffA);
            PG8_BAR; PG8_WAIT_L(0); PG8_MMA(1, 0, At, B0); PG8_BAR; PG8_SCHED;
            PG8_STAGE(PG8_SB(1, 1), b3 + hstep, voffB);
            PG8_WAIT_V(6); PG8_BAR; PG8_MMA(1, 1, At, B1); PG8_BAR;
            }
        }
        if constexpr (ALIGN_EPI) { if (wr == 0) PG8_BAR; }
        E(acc, cur, wr, wc, fr, fq); S.done(cur);
        if (!has_next) break;
#pragma unroll
        for (int a = 0; a < 2; ++a)
#pragma unroll
            for (int b = 0; b < 2; ++b)
#pragma unroll
                for (int m = 0; m < 4; ++m)
#pragma unroll
                    for (int n = 0; n < 2; ++n) acc[a][b][m][n] = (f32x4){0.f, 0.f, 0.f, 0.f};
        cur = nxt; cA = nA; cB = nB; ++ui;
        if constexpr (ALIGN_EPI) { if (wr == 1) PG8_BAR; }
    }
    PG8_WAIT_V(0);
    if constexpr (!ALIGN_EPI) { if (wr == 0) PG8_BAR; }
    PG8_BAR;
#undef PG8_SA
#undef PG8_SB
#undef PG8_STAGE
#undef PG8_LDA
#undef PG8_LDB
#undef PG8_MMA
#undef PG8_WAIT_V
#undef PG8_WAIT_L
#undef PG8_BAR
#undef PG8_SCHED
}
}

constexpr int NWAVES = 8;
#ifndef MK_N_LAUNCHES
#define MK_N_LAUNCHES 1
#endif
constexpr int PER_PHASE = 12;
constexpr int N_LAUNCHES = MK_N_LAUNCHES;
#ifndef WGM_P1
#define WGM_P1 8
#endif
#ifndef WGM_P6
#define WGM_P6 8
#endif
#ifndef WGM_P8
#define WGM_P8 8
#endif
#ifndef WGM_P9
#define WGM_P9 8
#endif
#ifndef GEMM_SP2
#define GEMM_SP2 true
#endif
#ifndef GEMM_ALIGN
#define GEMM_ALIGN true
#endif

constexpr int BATCH = 2, T = 8192, D = 4096, M = BATCH * T;
constexpr int SBH = 16, SBD = 128, RH = 8, RD = 256;
constexpr int NIN = 14336, FF = 16384;
constexpr int C_SBQ = 0, C_SBK = 2048, C_SBV = 4096, C_RQ = 6144, C_RK = 8192, C_RV = 10240, C_RG = 12288;
constexpr float EPS = 1e-6f;
constexpr float QSCALE = 0.12751743082459868f;

constexpr size_t MiB = 1u << 20;
constexpr size_t WS_CTL = 0, CTL_ZERO_BYTES = 1 * MiB;
constexpr size_t WS_XN = 1 * MiB;
constexpr size_t WS_WIN = 129 * MiB;
constexpr size_t WS_MIX = 129 * MiB;
constexpr size_t WS_MLP = 1 * MiB;
constexpr size_t WS_WOUT = 257 * MiB;
constexpr size_t WS_PROJ = 289 * MiB;
constexpr size_t WS_HID = 289 * MiB;
constexpr size_t WS_ROPE = 801 * MiB;
constexpr size_t WS_STATE = 809 * MiB;
constexpr size_t WS_ATT = 801 * MiB;
constexpr size_t WS_PART1 = 929 * MiB;
constexpr size_t WS_END = 935 * MiB;
constexpr int CW_TMO = 0, CW_CODE = 1, CW_BAR = 4096;

constexpr int RING_OFF = 0, RING_BYTES = 135168;
constexpr int LDSCTL_OFF = RING_BYTES, MISC_OFF = LDSCTL_OFF + 320;
constexpr int LDS_BYTES = 147456;

#define GAS __attribute__((address_space(1)))
#define LAS __attribute__((address_space(3)))
typedef unsigned short bf16;
typedef unsigned v4u __attribute__((ext_vector_type(4)));
typedef unsigned v2u __attribute__((ext_vector_type(2)));
typedef float f32x4 __attribute__((ext_vector_type(4)));
typedef GAS unsigned gu32;
#define RLX_AGENT __ATOMIC_RELAXED, __HIP_MEMORY_SCOPE_AGENT
#define LDS_WAIT() asm volatile("s_waitcnt lgkmcnt(0)" ::: "memory")
#define VM_WAIT() asm volatile("s_waitcnt vmcnt(0)" ::: "memory")
__device__ __forceinline__ unsigned f2bf(float f) { unsigned u = __builtin_bit_cast(unsigned, f); return (u + 0x7fffu + ((u >> 16) & 1u)) >> 16; }
__device__ __forceinline__ unsigned pk2(float lo, float hi) { return f2bf(lo) | (f2bf(hi) << 16); }
__device__ __forceinline__ float bf_lo(unsigned w) { return __builtin_bit_cast(float, w << 16); }
__device__ __forceinline__ float bf_hi(unsigned w) { return __builtin_bit_cast(float, w & 0xffff0000u); }

#define XB_TMO      128
#define XB_XCNT(j)  (256  + 64 * (j))
#define XB_XSUB(j)  (1280 + 64 * (j))
#define XB_XGEN(j)  (2304 + 64 * (j))
#define XB_TOP      3328
#define XB_TOPGEN   3392
#define XCD_BAR_WORDS 3456
#define XB_SPIN_CAP (1u << 18)

__device__ __forceinline__ unsigned xb_ld(unsigned* p)              { return __hip_atomic_load(p, __ATOMIC_RELAXED, __HIP_MEMORY_SCOPE_AGENT); }
__device__ __forceinline__ unsigned xb_add(unsigned* p, unsigned v) { return __hip_atomic_fetch_add(p, v, __ATOMIC_RELAXED, __HIP_MEMORY_SCOPE_AGENT); }
__device__ __forceinline__ unsigned xb_xcc_id() { return (unsigned)__builtin_amdgcn_s_getreg((3 << 11) | 20) & 0xFu; }
#define XB_SPIN(cond, bar) do { unsigned _sp = 0; while (cond) { __builtin_amdgcn_s_sleep(1); \
    if ((++_sp & 255u) == 0u) { if (xb_ld(&(bar)[XB_TMO])) break; if (_sp > XB_SPIN_CAP) { atomicAdd(&(bar)[XB_TMO], 1u); break; } } } } while (0)

struct XcdBarrier {
    unsigned* bar; unsigned x;
    volatile LAS unsigned* st;
};
__device__ __forceinline__ XcdBarrier xcd_barrier_post(unsigned* bar, volatile LAS unsigned* st) {
    XcdBarrier b; b.bar = bar; b.x = xb_xcc_id(); b.st = st;
    if (threadIdx.x == 0) (void)xb_add(&bar[XB_XCNT(b.x)], 1u);
    return b;
}
__device__ __forceinline__ void xcd_barrier_complete(unsigned* bar, unsigned x, unsigned& nloc, unsigned& nx) {
    const unsigned G = gridDim.x * gridDim.y * gridDim.z;
    unsigned sum, cnt, mine, sp = 0u;
    for (;;) {
        sum = 0u; cnt = 0u; mine = 0u;
#pragma unroll
        for (unsigned j = 0; j < 16; ++j) { const unsigned c = xb_ld(&bar[XB_XCNT(j)]); sum += c; cnt += (c > 0u) ? 1u : 0u; mine = (j == x) ? c : mine; }
        if (sum == G) break;
        __builtin_amdgcn_s_sleep(1);
        if ((++sp & 255u) == 0u) { if (xb_ld(&bar[XB_TMO])) break; if (sp > XB_SPIN_CAP) { atomicAdd(&bar[XB_TMO], 1u); break; } }
    }
    nloc = mine > 0u ? mine : 1u; nx = cnt > 0u ? cnt : 1u;
}
__device__ __forceinline__ void xcd_barrier(const XcdBarrier& b) {
    asm volatile("s_waitcnt vmcnt(0)" ::: "memory");
    __syncthreads();
    if (threadIdx.x == 0) {
        unsigned* bar = b.bar;
        __builtin_amdgcn_s_waitcnt(0);
        unsigned nloc = b.st[0], nx = b.st[1];
        if (nloc == 0u) { xcd_barrier_complete(bar, b.x, nloc, nx); b.st[0] = nloc; b.st[1] = nx; }
        const unsigned old = xb_add(&bar[XB_XSUB(b.x)], 1u);
        const unsigned gen = old / nloc;
        if (old + 1u == (gen + 1u) * nloc) {
            __builtin_amdgcn_fence(__ATOMIC_RELEASE, "agent");
            asm volatile("s_waitcnt vmcnt(0)" ::: "memory");
            const unsigned og = xb_add(&bar[XB_TOP], 1u);
            const unsigned tg = og / nx;
            if (og + 1u == (tg + 1u) * nx) xb_add(&bar[XB_TOPGEN], 1u);
            else XB_SPIN(xb_ld(&bar[XB_TOPGEN]) == tg, bar);
            __builtin_amdgcn_fence(__ATOMIC_ACQUIRE, "agent");
            xb_add(&bar[XB_XGEN(b.x)], 1u);
            asm volatile("s_waitcnt vmcnt(0)" ::: "memory");
        } else {
            XB_SPIN(xb_ld(&bar[XB_XGEN(b.x)]) == gen, bar);
            __builtin_amdgcn_fence(__ATOMIC_ACQUIRE, "agent");
            asm volatile("s_waitcnt vmcnt(0)" ::: "memory");
        }
    }
    __syncthreads();
}

struct Frame {
    LAS unsigned char* lds;
    volatile LAS unsigned* MISC;
    gu32* ctl;
    int tid, lane, wave;
    int vcu, G;
    const float* x; float* out;
    const float *g_attn, *w_in, *g_sb, *g_ret, *w_out, *g_mlp, *w_up, *w_down, *g_fin;
    bf16 *XN, *WIN, *WOUT, *PROJ, *MIX, *WUP, *HID, *WDOWN, *ATT, *MLP;
    float *SBO, *ROPE, *UT, *PART1, *PARTSB, *RSTDX; bf16* ST;
};

__device__ __forceinline__ float wave_sum(float v) {
#pragma unroll
    for (int o = 1; o < 64; o <<= 1) v += __shfl_xor(v, o);
    return v;
}
__device__ __forceinline__ void p0_transpose_item(const float* W, int K, int N, bf16* WT, LAS float* scr, int item, int lane, const float* gk) {
    const int nblk = N / 32, kb = item / nblk, nb = item % nblk, k0 = 64 * kb, n0 = 32 * nb;
    float tv[32];
#pragma unroll
    for (int i = 0; i < 32; ++i) tv[i] = W[(size_t)(k0 + 2 * i + (lane >> 5)) * N + n0 + (lane & 31)];
    if (gk) {
#pragma unroll
        for (int i = 0; i < 32; ++i) tv[i] *= gk[k0 + 2 * i + (lane >> 5)];
    }
#pragma unroll
    for (int i = 0; i < 32; ++i) scr[(2 * i + (lane >> 5)) * 33 + (lane & 31)] = tv[i];
    LDS_WAIT(); asm volatile("" ::: "memory");
    const int c = lane & 7;
#pragma unroll
    for (int j = 0; j < 4; ++j) { const int n = (lane >> 3) + 8 * j; const LAS float* s = scr + (8 * c) * 33 + n;
        v4u o; o.x = pk2(s[0 * 33], s[1 * 33]); o.y = pk2(s[2 * 33], s[3 * 33]); o.z = pk2(s[4 * 33], s[5 * 33]); o.w = pk2(s[6 * 33], s[7 * 33]);
        *(GAS v4u*)(WT + (size_t)(n0 + n) * K + k0 + 8 * c) = o; }
    LDS_WAIT(); asm volatile("" ::: "memory");
}
__device__ __forceinline__ void transpose_matrix(Frame& F, const float* W, int K, int N, bf16* WT, const float* gk = nullptr, int gk_rows = 0) {
    LAS float* scr = (LAS float*)(F.lds + RING_OFF + F.wave * 16384);
    const int gw = F.vcu * NWAVES + F.wave, NGW = F.G * NWAVES;
    const int nitems = (K / 64) * (N / 32);
    for (int it = gw; it < nitems; it += NGW) p0_transpose_item(W, K, N, WT, scr, it, F.lane, (64 * (it / (N / 32)) < gk_rows) ? gk : nullptr);
}
template <int NJ, bool OUT_BF16>
__device__ __forceinline__ void rms_row(const float* xrow, const bf16* a1row, const bf16* a2row, const float* g, void* orow, int lane) {
    const GAS f32x4* xr = (const GAS f32x4*)xrow + lane;
    f32x4 v[NJ]; float s = 0.f;
#pragma unroll
    for (int j = 0; j < NJ; ++j) v[j] = xr[64 * j];
    if (a1row) {
        const GAS v2u* ar = (const GAS v2u*)a1row + lane;
#pragma unroll
        for (int j = 0; j < NJ; ++j) { const v2u w = ar[64 * j]; v[j] += (f32x4){bf_lo(w.x), bf_hi(w.x), bf_lo(w.y), bf_hi(w.y)}; }
    }
    if (a2row) {
        const GAS v2u* ar = (const GAS v2u*)a2row + lane;
#pragma unroll
        for (int j = 0; j < NJ; ++j) { const v2u w = ar[64 * j]; v[j] += (f32x4){bf_lo(w.x), bf_hi(w.x), bf_lo(w.y), bf_hi(w.y)}; }
    }
#pragma unroll
    for (int j = 0; j < NJ; ++j) s += (v[j].x * v[j].x + v[j].y * v[j].y) + (v[j].z * v[j].z + v[j].w * v[j].w);
    const float rstd = 1.0f / sqrtf(wave_sum(s) * (1.f / (256.f * NJ)) + EPS);
    const GAS f32x4* gr = (const GAS f32x4*)g + lane;
#pragma unroll
    for (int j = 0; j < NJ; ++j) { const f32x4 gg = gr[64 * j]; const f32x4 y = v[j] * rstd * gg;
        if constexpr (OUT_BF16) { v2u o; o.x = pk2(y.x, y.y); o.y = pk2(y.z, y.w); ((GAS v2u*)orow)[lane + 64 * j] = o; }
        else ((GAS f32x4*)orow)[lane + 64 * j] = y; }
}

__device__ __forceinline__ void cvt_row_rstd(const float* xrow, bf16* orow, float* rstd_out, int lane) {
    const GAS f32x4* xr = (const GAS f32x4*)xrow + lane;
    f32x4 v[16]; float s = 0.f;
#pragma unroll
    for (int j = 0; j < 16; ++j) v[j] = xr[64 * j];
#pragma unroll
    for (int j = 0; j < 16; ++j) { s += (v[j].x * v[j].x + v[j].y * v[j].y) + (v[j].z * v[j].z + v[j].w * v[j].w);
        v2u o; o.x = pk2(v[j].x, v[j].y); o.y = pk2(v[j].z, v[j].w); ((GAS v2u*)orow)[lane + 64 * j] = o; }
    const float rstd = 1.0f / sqrtf(wave_sum(s) * (1.f / 4096.f) + EPS);
    if (lane == 0) *rstd_out = rstd;
}

__device__ __forceinline__ void rms_row_bb(const bf16* a1row, const bf16* a2row, const float* g, float* orow, int lane) {
    const GAS v2u* ar = (const GAS v2u*)a1row + lane; const GAS v2u* br = (const GAS v2u*)a2row + lane;
    f32x4 v[16]; float s = 0.f;
#pragma unroll
    for (int j = 0; j < 16; ++j) { const v2u w = ar[64 * j]; v[j] = (f32x4){bf_lo(w.x), bf_hi(w.x), bf_lo(w.y), bf_hi(w.y)}; }
#pragma unroll
    for (int j = 0; j < 16; ++j) { const v2u w = br[64 * j]; v[j] += (f32x4){bf_lo(w.x), bf_hi(w.x), bf_lo(w.y), bf_hi(w.y)}; }
#pragma unroll
    for (int j = 0; j < 16; ++j) s += (v[j].x * v[j].x + v[j].y * v[j].y) + (v[j].z * v[j].z + v[j].w * v[j].w);
    const float rstd = 1.0f / sqrtf(wave_sum(s) * (1.f / 4096.f) + EPS);
    const GAS f32x4* gr = (const GAS f32x4*)g + lane;
#pragma unroll
    for (int j = 0; j < 16; ++j) ((GAS f32x4*)orow)[lane + 64 * j] = v[j] * rstd * gr[64 * j];
}

__constant__ float c_log2g[8] = { -0.04580368961312479f, -0.02272007650008353f, -0.011315313227834146f, -0.005646563141142063f,
                                  -0.0028205190623786626f, -0.0014095702546713536f, -0.0007046129765893727f, -0.0003522634716290214f };
struct EpiProj {
    static constexpr bool PERM = true, AFTER_DRAIN = false;
    bf16* O; const float* rope; const LAS float* tab;
    __device__ __forceinline__ void operator()(const pg8::f32x4 (&acc)[2][2][4][2], const pg8::Unit& u, int wr, int wc, int fr, int fq) const {
        const int kind = u.pn >> 3;
        const int row0 = u.pm * 256 + wr * 64 + fr, col0 = u.pn * 256 + wc * 32 + 8 * fq;
        if (kind == 3 || kind == 4) {
            const float L = c_log2g[u.pn & 7] * (kind == 3 ? 1.f : -1.f), mul = (kind == 3) ? 1.f : 0.0625f;
            const int i0 = wc * 32 + 8 * fq;
#pragma unroll
            for (int ai = 0; ai < 2; ++ai)
#pragma unroll
                for (int m = 0; m < 4; ++m) {
                    const int row = row0 + ai * 128 + m * 16, pos = row & (T - 1), tl = row & 255;
                    const float sc = __builtin_amdgcn_exp2f((float)(tl + 1) * L) * mul * tab[ai * 128 + wr * 64 + m * 16 + fr];
                    const float* cp = rope + (size_t)pos * 128 + i0; const float* sp = cp + (size_t)T * 128;
                    const f32x4 c0 = *(const f32x4*)cp, c1 = *(const f32x4*)(cp + 4), s0 = *(const f32x4*)sp, s1 = *(const f32x4*)(sp + 4);
                    const f32x4 a0 = acc[ai][0][m][0], a1 = acc[ai][0][m][1], b0 = acc[ai][1][m][0], b1 = acc[ai][1][m][1];
                    const f32x4 y0 = (a0 * c0 - b0 * s0) * sc, y1 = (a1 * c1 - b1 * s1) * sc, z0 = (b0 * c0 + a0 * s0) * sc, z1 = (b1 * c1 + a1 * s1) * sc;
                    bf16* rowp = O + (size_t)row * NIN + col0;
                    v4u w; w.x = pg8::cvt_pk_bf16(y0[0], y0[1]); w.y = pg8::cvt_pk_bf16(y0[2], y0[3]); w.z = pg8::cvt_pk_bf16(y1[0], y1[1]); w.w = pg8::cvt_pk_bf16(y1[2], y1[3]);
                    *(v4u*)rowp = w;
                    v4u w2; w2.x = pg8::cvt_pk_bf16(z0[0], z0[1]); w2.y = pg8::cvt_pk_bf16(z0[2], z0[3]); w2.z = pg8::cvt_pk_bf16(z1[0], z1[1]); w2.w = pg8::cvt_pk_bf16(z1[2], z1[3]);
                    *(v4u*)(rowp + 128) = w2;
                }
        } else {
            const float sc0 = (kind == 0) ? QSCALE : 1.f;
#pragma unroll
            for (int ai = 0; ai < 2; ++ai)
#pragma unroll
                for (int m = 0; m < 4; ++m) { bf16* rowp = O + (size_t)(row0 + ai * 128 + m * 16) * NIN + col0; const float sc = sc0 * tab[ai * 128 + wr * 64 + m * 16 + fr];
#pragma unroll
                    for (int bj = 0; bj < 2; ++bj) { f32x4 v0 = acc[ai][bj][m][0] * sc, v1 = acc[ai][bj][m][1] * sc;
                        if (kind == 6) {
#pragma unroll
                            for (int j = 0; j < 4; ++j) { v0[j] = v0[j] * __builtin_amdgcn_rcpf(1.f + __builtin_amdgcn_exp2f(-1.4426950408889634f * v0[j]));
                                                          v1[j] = v1[j] * __builtin_amdgcn_rcpf(1.f + __builtin_amdgcn_exp2f(-1.4426950408889634f * v1[j])); } }
                        v4u w; w.x = pg8::cvt_pk_bf16(v0[0], v0[1]); w.y = pg8::cvt_pk_bf16(v0[2], v0[3]); w.z = pg8::cvt_pk_bf16(v1[0], v1[1]); w.w = pg8::cvt_pk_bf16(v1[2], v1[3]);
                        *(v4u*)(rowp + bj * 128) = w; } }
        }
    }
};
struct EpiBf16 {
    static constexpr bool PERM = true, AFTER_DRAIN = false;
    bf16* O; int ldc;
    __device__ __forceinline__ void operator()(const pg8::f32x4 (&acc)[2][2][4][2], const pg8::Unit& u, int wr, int wc, int fr, int fq) const {
        const int row0 = u.pm * 256 + wr * 64 + fr, col0 = u.pn * 256 + wc * 32 + 8 * fq;
#pragma unroll
        for (int ai = 0; ai < 2; ++ai)
#pragma unroll
            for (int m = 0; m < 4; ++m) { bf16* rowp = O + (size_t)(row0 + ai * 128 + m * 16) * ldc + col0;
#pragma unroll
                for (int bj = 0; bj < 2; ++bj) { const f32x4 v0 = acc[ai][bj][m][0], v1 = acc[ai][bj][m][1];
                    v4u w; w.x = pg8::cvt_pk_bf16(v0[0], v0[1]); w.y = pg8::cvt_pk_bf16(v0[2], v0[3]); w.z = pg8::cvt_pk_bf16(v1[0], v1[1]); w.w = pg8::cvt_pk_bf16(v1[2], v1[3]);
                    *(v4u*)(rowp + bj * 128) = w; } }
    }
};
struct ScaleRowsAt {
    static constexpr bool ACTIVE = true;
    int T0; const LAS float* tab;
    __device__ __forceinline__ void operator()(int t, pg8::f32x4 (&acc)[2][2][4][2], int wr, int fr) const {
        if (t != T0) return;
#pragma unroll
        for (int ai = 0; ai < 2; ++ai)
#pragma unroll
            for (int m = 0; m < 4; ++m) { const float rs = tab[ai * 128 + wr * 64 + m * 16 + fr];
#pragma unroll
                for (int bj = 0; bj < 2; ++bj)
#pragma unroll
                    for (int n = 0; n < 2; ++n) acc[ai][bj][m][n] = acc[ai][bj][m][n] * rs; }
    }
};
struct EpiX1 {
    static constexpr bool PERM = true, AFTER_DRAIN = false;
    const bf16* x; bf16* O; float* part; int ldc;
    __device__ __forceinline__ void operator()(const pg8::f32x4 (&acc)[2][2][4][2], const pg8::Unit& u, int wr, int wc, int fr, int fq) const {
        const int row0 = u.pm * 256 + wr * 64 + fr, col0 = u.pn * 256 + wc * 32 + 8 * fq;
#pragma unroll
        for (int ai = 0; ai < 2; ++ai)
#pragma unroll
            for (int m = 0; m < 4; ++m) { const int row = row0 + ai * 128 + m * 16; const bf16* xr = x + (size_t)row * ldc + col0; bf16* rowp = O + (size_t)row * ldc + col0;
                float s = 0.f;
#pragma unroll
                for (int bj = 0; bj < 2; ++bj) { const v4u xw = *(const v4u*)(xr + bj * 128);
                    const f32x4 v0 = acc[ai][bj][m][0] + (f32x4){bf_lo(xw.x), bf_hi(xw.x), bf_lo(xw.y), bf_hi(xw.y)}, v1 = acc[ai][bj][m][1] + (f32x4){bf_lo(xw.z), bf_hi(xw.z), bf_lo(xw.w), bf_hi(xw.w)};
                    s += (v0[0] * v0[0] + v0[1] * v0[1]) + (v0[2] * v0[2] + v0[3] * v0[3]) + (v1[0] * v1[0] + v1[1] * v1[1]) + (v1[2] * v1[2] + v1[3] * v1[3]);
                    v4u w; w.x = pg8::cvt_pk_bf16(v0[0], v0[1]); w.y = pg8::cvt_pk_bf16(v0[2], v0[3]); w.z = pg8::cvt_pk_bf16(v1[0], v1[1]); w.w = pg8::cvt_pk_bf16(v1[2], v1[3]);
                    *(v4u*)(rowp + bj * 128) = w; }
                s += __shfl_xor(s, 16); s += __shfl_xor(s, 32);
                if (fq == 0) part[(size_t)row * 64 + u.pn * 4 + wc] = s; }
    }
};
struct EpiRelu2S {
    static constexpr bool PERM = true, AFTER_DRAIN = false;
    bf16* O; int ldc; const LAS float* tab;
    __device__ __forceinline__ void operator()(const pg8::f32x4 (&acc)[2][2][4][2], const pg8::Unit& u, int wr, int wc, int fr, int fq) const {
        const int row0 = u.pm * 256 + wr * 64 + fr, col0 = u.pn * 256 + wc * 32 + 8 * fq;
#pragma unroll
        for (int ai = 0; ai < 2; ++ai)
#pragma unroll
            for (int m = 0; m < 4; ++m) { bf16* rowp = O + (size_t)(row0 + ai * 128 + m * 16) * ldc + col0; const float rs = tab[ai * 128 + wr * 64 + m * 16 + fr];
#pragma unroll
                for (int bj = 0; bj < 2; ++bj) { f32x4 v0 = acc[ai][bj][m][0], v1 = acc[ai][bj][m][1];
#pragma unroll
                    for (int j = 0; j < 4; ++j) { const float a = fmaxf(v0[j], 0.f) * rs, b = fmaxf(v1[j], 0.f) * rs; v0[j] = a * a; v1[j] = b * b; }
                    v4u w; w.x = pg8::cvt_pk_bf16(v0[0], v0[1]); w.y = pg8::cvt_pk_bf16(v0[2], v0[3]); w.z = pg8::cvt_pk_bf16(v1[0], v1[1]); w.w = pg8::cvt_pk_bf16(v1[2], v1[3]);
                    *(v4u*)(rowp + bj * 128) = w; } }
    }
};

__device__ __forceinline__ void p0_prologue(Frame& F) {
    transpose_matrix(F, F.w_in, D, NIN, F.WIN, F.g_attn, D);
    transpose_matrix(F, F.w_out, D, D, F.WOUT, F.g_sb, 2048);
    transpose_matrix(F, F.w_up, D, FF, F.WUP, F.g_mlp, D);
    transpose_matrix(F, F.w_down, FF, D, F.WDOWN);
    const int gw = F.vcu * NWAVES + F.wave, NGW = F.G * NWAVES;
    for (int m = gw; m < M; m += NGW) cvt_row_rstd(F.x + (size_t)m * D, F.XN + (size_t)m * D, F.RSTDX + m, F.lane);
    for (int e = (F.vcu * NWAVES + F.wave) * 64 + F.lane; e < T * 128; e += NGW * 64) {
        const int pos = e >> 7, i = e & 127;
        const double inv = exp2(-(double)i * 0.10381025296523007);
        const double rev = (double)pos * inv * 0.15915494309189535;
        const float fr = (float)(rev - floor(rev));
        F.ROPE[e] = __builtin_amdgcn_cosf(fr); F.ROPE[(size_t)T * 128 + e] = __builtin_amdgcn_sinf(fr);
    }
}

namespace sba {
using bf16x8 = __attribute__((ext_vector_type(8))) short;
using s16x4  = __attribute__((ext_vector_type(4))) short;
using f32x16 = __attribute__((ext_vector_type(16))) float;
using u32x4  = __attribute__((ext_vector_type(4))) unsigned;
constexpr int DH = 128, KVBLK = 64, LDK = NIN;
constexpr int SHM_V = KVBLK * DH * 2, SHM_K = KVBLK * DH * 2;
#define SBA_KSWZ(row, colB) ((row) * 256 + ((colB) ^ (((row) & 7) << 4)))
#define SBA_SBAR() __builtin_amdgcn_sched_barrier(0)
__device__ __forceinline__ int crow(int r, int hi) { return (r & 3) + 8 * (r >> 2) + 4 * hi; }
__device__ __forceinline__ unsigned cvtpk(float lo, float hi) { unsigned r; asm volatile("v_cvt_pk_bf16_f32 %0, %1, %2" : "=v"(r) : "v"(lo), "v"(hi)); return r; }
__device__ __forceinline__ void qkt(f32x16& p0, f32x16& p1, const char* Ks, const char* Qs, int r32, int hi) {
  p0 = f32x16{}; p1 = f32x16{};
#pragma unroll
  for (int d0 = 0; d0 < 8; ++d0) { const int cb = (d0 * 16 + hi * 8) * 2;
    const bf16x8 b0 = *reinterpret_cast<const bf16x8*>(Ks + SBA_KSWZ(r32, cb));
    const bf16x8 b1 = *reinterpret_cast<const bf16x8*>(Ks + SBA_KSWZ(32 + r32, cb));
    const bf16x8 q = *reinterpret_cast<const bf16x8*>(Qs + d0 * 1024);
    p0 = __builtin_amdgcn_mfma_f32_32x32x16_bf16(b0, q, p0, 0, 0, 0);
    p1 = __builtin_amdgcn_mfma_f32_32x32x16_bf16(b1, q, p1, 0, 0, 0); }
}
__device__ __forceinline__ int v_st(int k, int c) { const int kk = (k & ~0xC) | ((k & 4) << 1) | ((k & 8) >> 1); return ((kk >> 3) * 4 + (c >> 5)) * 512 + ((kk & 7) * 32 + (c & 31)) * 2; }
__device__ __forceinline__ int v_rd_base(int lane) { return ((lane & 3) << 3) | (((lane >> 2) & 3) << 6) | (((lane >> 4) & 1) << 5) | (((lane >> 5) & 1) << 8); }
constexpr int v_rd_off(int d0, int ks, int half) { return d0 * 512 + ks * 4096 + half * 2048; }
template <int OFF> __device__ __forceinline__ s16x4 tr_read(int vb) {
  s16x4 r; asm volatile("ds_read_b64_tr_b16 %0, %1 offset:%2" : "=&v"(r) : "v"(vb), "i"(OFF) : "memory"); return r;
}
template <int D0> __device__ __forceinline__ void pv_one(f32x16& od, int vb, bf16x8 pa0, bf16x8 pa1, bf16x8 pa2, bf16x8 pa3) {
  const s16x4 l0 = tr_read<v_rd_off(D0, 0, 0)>(vb), h0 = tr_read<v_rd_off(D0, 0, 1)>(vb), l1 = tr_read<v_rd_off(D0, 1, 0)>(vb), h1 = tr_read<v_rd_off(D0, 1, 1)>(vb);
  const s16x4 l2 = tr_read<v_rd_off(D0, 2, 0)>(vb), h2 = tr_read<v_rd_off(D0, 2, 1)>(vb), l3 = tr_read<v_rd_off(D0, 3, 0)>(vb), h3 = tr_read<v_rd_off(D0, 3, 1)>(vb);
  asm volatile("s_waitcnt lgkmcnt(0)" ::: "memory"); SBA_SBAR();
#define SBA_PK(L, H) (bf16x8){L[0], L[1], L[2], L[3], H[0], H[1], H[2], H[3]}
  od = __builtin_amdgcn_mfma_f32_32x32x16_bf16(pa0, SBA_PK(l0, h0), od, 0, 0, 0);
  od = __builtin_amdgcn_mfma_f32_32x32x16_bf16(pa1, SBA_PK(l1, h1), od, 0, 0, 0);
  od = __builtin_amdgcn_mfma_f32_32x32x16_bf16(pa2, SBA_PK(l2, h2), od, 0, 0, 0);
  od = __builtin_amdgcn_mfma_f32_32x32x16_bf16(pa3, SBA_PK(l3, h3), od, 0, 0, 0);
#undef SBA_PK
}
template <bool MASKED>
__device__ __forceinline__ void sb_weights(f32x16& p0, f32x16& p1, float& R, int hi, int lim) {
#pragma unroll
  for (int r = 0; r < 16; ++r) {
    const float e0 = __builtin_amdgcn_exp2f(-p0[r]), e1 = __builtin_amdgcn_exp2f(-p1[r]);
    float b0 = __builtin_amdgcn_rcpf(1.f + e0), b1 = __builtin_amdgcn_rcpf(1.f + e1);
    if (MASKED) { b0 = (crow(r, hi) < lim) ? b0 : 0.f; b1 = (32 + crow(r, hi) < lim) ? b1 : 0.f; }
    p0[r] = b0; p1[r] = b1;
  }
  float run = R;
#pragma unroll
  for (int G = 7; G >= 0; --G) {
    float gp;
    if (G < 4) gp = ((1.f - p0[4 * G]) * (1.f - p0[4 * G + 1])) * ((1.f - p0[4 * G + 2]) * (1.f - p0[4 * G + 3]));
    else       gp = ((1.f - p1[4 * G - 16]) * (1.f - p1[4 * G - 15])) * ((1.f - p1[4 * G - 14]) * (1.f - p1[4 * G - 13]));
    const auto rr = __builtin_amdgcn_permlane32_swap(__float_as_uint(gp), __float_as_uint(gp), false, false);
    const float glo = __uint_as_float(rr[0]), ghi = __uint_as_float(rr[1]);
    float t = run * (hi ? 1.f : ghi);
    if (G < 4) {
      const float a3 = p0[4 * G + 3] * t; t -= a3; const float a2 = p0[4 * G + 2] * t; t -= a2; const float a1 = p0[4 * G + 1] * t; t -= a1; const float a0 = p0[4 * G] * t;
      p0[4 * G] = a0; p0[4 * G + 1] = a1; p0[4 * G + 2] = a2; p0[4 * G + 3] = a3;
    } else {
      const int g = G - 4;
      const float a3 = p1[4 * g + 3] * t; t -= a3; const float a2 = p1[4 * g + 2] * t; t -= a2; const float a1 = p1[4 * g + 1] * t; t -= a1; const float a0 = p1[4 * g] * t;
      p1[4 * g] = a0; p1[4 * g + 1] = a1; p1[4 * g + 2] = a2; p1[4 * g + 3] = a3;
    }
    run *= glo * ghi;
  }
  R = run;
}
__device__ __forceinline__ void pack_p(const f32x16& p0, const f32x16& p1, bf16x8& pa0, bf16x8& pa1, bf16x8& pa2, bf16x8& pa3) {
#define SBA_PK4(P, BASE, OUT) do { unsigned a0 = cvtpk(P[BASE + 0], P[BASE + 1]), a1 = cvtpk(P[BASE + 2], P[BASE + 3]);   \
    unsigned b0 = cvtpk(P[BASE + 4], P[BASE + 5]), b1 = cvtpk(P[BASE + 6], P[BASE + 7]);                              \
    auto r0 = __builtin_amdgcn_permlane32_swap(a0, b0, false, false); auto r1 = __builtin_amdgcn_permlane32_swap(a1, b1, false, false); \
    u32x4 w = {r0[0], r1[0], r0[1], r1[1]}; OUT = *reinterpret_cast<bf16x8*>(&w); } while (0)
  SBA_PK4(p0, 0, pa0); SBA_PK4(p0, 8, pa1); SBA_PK4(p1, 0, pa2); SBA_PK4(p1, 8, pa3);
#undef SBA_PK4
}
__device__ __forceinline__ void unit(const bf16* __restrict__ Qh, const bf16* __restrict__ Kh, const bf16* __restrict__ Vh, bf16* __restrict__ Oh, float* __restrict__ Ph, int q0, char* lds) {
  int tid = threadIdx.x; asm volatile("" : "+v"(tid));
  const int wid = tid >> 6, lane = tid & 63, r32 = lane & 31, hi = lane >> 5;
  char* V_lds = lds; char* K_lds = lds + 2 * SHM_V;
  volatile int* flags = (volatile int*)(lds + LDSCTL_OFF);
  char* Qs = lds + 2 * SHM_V + 2 * SHM_K + wid * 8192 + lane * 16;
  f32x16 o[4] = {};
  const int qrow0 = q0 + wid * 32;
  bf16x8 qv[8];
  { const bf16* Qw = Qh + (size_t)(qrow0 + r32) * LDK + hi * 8;
#pragma unroll
    for (int d0 = 0; d0 < 8; ++d0) qv[d0] = *reinterpret_cast<const bf16x8*>(Qw + d0 * 16); }
  const int sr = tid >> 4, sc = (tid & 15) * 8, vst0 = v_st(sr, sc), vst1 = v_st(32 + sr, sc);
  const int vb0 = (int)(uintptr_t)V_lds + v_rd_base(lane);
  bf16x8 vsA0, vsA1, ksA0, ksA1, vsB0, vsB1, ksB0, ksB1;
#define SBA_SLOAD(S, k0) do { vs##S##0 = *reinterpret_cast<const bf16x8*>(&Vh[(size_t)((k0) + sr) * LDK + sc]); vs##S##1 = *reinterpret_cast<const bf16x8*>(&Vh[(size_t)((k0) + 32 + sr) * LDK + sc]); \
    ks##S##0 = *reinterpret_cast<const bf16x8*>(&Kh[(size_t)((k0) + sr) * LDK + sc]); ks##S##1 = *reinterpret_cast<const bf16x8*>(&Kh[(size_t)((k0) + 32 + sr) * LDK + sc]); } while (0)
#define SBA_SWRITE(S, b) do { *(bf16x8*)(V_lds + (b) * SHM_V + vst0) = vs##S##0; *(bf16x8*)(V_lds + (b) * SHM_V + vst1) = vs##S##1; const int kc = sc * 2; \
    *(bf16x8*)(K_lds + (b) * SHM_K + SBA_KSWZ(sr, kc)) = ks##S##0; *(bf16x8*)(K_lds + (b) * SHM_K + SBA_KSWZ(32 + sr, kc)) = ks##S##1; } while (0)
#define SBA_TILE(j, buf) do { const int k0 = (NT - 1 - (j)) * KVBLK; const int lim = qrow0 + r32 - k0; const bool live = __any(R != 0.f); \
    if (k0 < qrow0 + 32 && live) { f32x16 p0, p1; bf16x8 pa0, pa1, pa2, pa3; \
      qkt(p0, p1, K_lds + (buf) * SHM_K, Qs, r32, hi); \
      if (k0 + KVBLK <= qrow0) sb_weights<false>(p0, p1, R, hi, lim); else sb_weights<true>(p0, p1, R, hi, lim); \
      pack_p(p0, p1, pa0, pa1, pa2, pa3); const int vb = vb0 + (buf) * SHM_V; \
      pv_one<0>(o[0], vb, pa0, pa1, pa2, pa3); pv_one<1>(o[1], vb, pa0, pa1, pa2, pa3); pv_one<2>(o[2], vb, pa0, pa1, pa2, pa3); pv_one<3>(o[3], vb, pa0, pa1, pa2, pa3); } \
    { const int al = __any(R != 0.f) ? 1 : 0; if (lane == 0) flags[wid] = al; } } while (0)
#define SBA_ALIVE(j) ({ int alive_ = 0; _Pragma("unroll") for (int w_ = 0; w_ < 8; ++w_) alive_ |= flags[w_]; flags = (volatile int*)(lds + LDSCTL_OFF + (((j) + 1) & 1) * 32); alive_; })
  const int NT = (q0 + 256) / KVBLK;
  float R = 1.f;
  SBA_SLOAD(A, (NT - 1) * KVBLK); SBA_SLOAD(B, (NT - 2) * KVBLK);
  __syncthreads();
#pragma unroll
  for (int d0 = 0; d0 < 8; ++d0) *reinterpret_cast<bf16x8*>(Qs + d0 * 1024) = qv[d0];
  SBA_SWRITE(A, 0); __syncthreads();
  for (int j = 0; j < NT; j += 2) {
    if (j + 2 < NT) SBA_SLOAD(A, (NT - 3 - j) * KVBLK);
    SBA_TILE(j, 0);
    SBA_SWRITE(B, 1);
    __syncthreads();
    if (!SBA_ALIVE(j)) break;
    if (j + 3 < NT) SBA_SLOAD(B, (NT - 4 - j) * KVBLK);
    SBA_TILE(j + 1, 1);
    if (j + 2 < NT) SBA_SWRITE(A, 0);
    __syncthreads();
    if (!SBA_ALIVE(j + 1)) break;
  }
#undef SBA_TILE
#undef SBA_ALIVE
  bf16* Ow = Oh + (size_t)qrow0 * D;
#pragma unroll
  for (int r = 0; r < 16; ++r) { const int orow = crow(r, hi);
    float s = (o[0][r] * o[0][r] + o[1][r] * o[1][r]) + (o[2][r] * o[2][r] + o[3][r] * o[3][r]);
#pragma unroll
    for (int d0 = 0; d0 < 4; ++d0) Ow[(size_t)orow * D + d0 * 32 + r32] = (bf16)f2bf(o[d0][r]);
    s += __shfl_xor(s, 1); s += __shfl_xor(s, 2); s += __shfl_xor(s, 4); s += __shfl_xor(s, 8); s += __shfl_xor(s, 16);
    if (r32 == 0) Ph[(size_t)(qrow0 + orow) * 16] = s; }
#undef SBA_SLOAD
#undef SBA_SWRITE
}
}

__device__ __forceinline__ void sb_fast_phase(Frame& F) {
  for (int p = blockIdx.x; p < 512; p += F.G) {
    const int bh = p >> 4, x = p & 15, b = bh >> 4, h = bh & 15;
    const bf16* base = F.PROJ + (size_t)b * T * NIN + h * SBD;
    bf16* Oh = F.MIX + (size_t)b * T * D + h * SBD; float* Ph = F.PARTSB + (size_t)b * T * 16 + h;
    sba::unit(base + C_SBQ, base + C_SBK, base + C_SBV, Oh, Ph, (31 - x) * 256, (char*)F.lds);
    sba::unit(base + C_SBQ, base + C_SBK, base + C_SBV, Oh, Ph, x * 256, (char*)F.lds);
  }
  __syncthreads();
}


namespace ret {
using sba::bf16x8; using sba::s16x4; using sba::f32x16; using sba::u32x4; using sba::crow; using sba::v_st; using sba::v_rd_base; using sba::v_rd_off; using sba::tr_read;
constexpr int IMG = 16384;
template <int D0, int KS> __device__ __forceinline__ bf16x8 tr_frag(int vb) {
  const s16x4 l = tr_read<v_rd_off(D0, KS, 0)>(vb), h = tr_read<v_rd_off(D0, KS, 1)>(vb);
  return (bf16x8){l[0], l[1], l[2], l[3], h[0], h[1], h[2], h[3]};
}
__device__ __forceinline__ void tile_load(bf16x8 (&v)[4], const bf16* __restrict__ src, size_t pitch, int tid) {
  const int sr = tid >> 4, sc = (tid & 15) * 8;
#pragma unroll
  for (int i = 0; i < 4; ++i) v[i] = *reinterpret_cast<const bf16x8*>(src + (size_t)(sr + 32 * (i & 1)) * pitch + (i >> 1) * 128 + sc);
}
template <bool VST> __device__ __forceinline__ void tile_write(const bf16x8 (&v)[4], char* dst, int tid) {
  const int sr = tid >> 4, sc = (tid & 15) * 8;
#pragma unroll
  for (int i = 0; i < 4; ++i) { const int row = sr + 32 * (i & 1); const int off = VST ? v_st(row, sc) : SBA_KSWZ(row, sc * 2);
    *reinterpret_cast<bf16x8*>(dst + (i >> 1) * IMG + off) = v[i]; }
}
template <int KS> __device__ __forceinline__ void passA_step(f32x16 (&acc)[2][4], int vbV, int vbK) {
  const bf16x8 a0 = tr_frag<0, KS>(vbV), a1 = tr_frag<1, KS>(vbV);
  const bf16x8 b0 = tr_frag<0, KS>(vbK), b1 = tr_frag<1, KS>(vbK), b2 = tr_frag<2, KS>(vbK), b3 = tr_frag<3, KS>(vbK);
  asm volatile("s_waitcnt lgkmcnt(0)" ::: "memory"); SBA_SBAR();
  acc[0][0] = __builtin_amdgcn_mfma_f32_32x32x16_bf16(a0, b0, acc[0][0], 0, 0, 0); acc[0][1] = __builtin_amdgcn_mfma_f32_32x32x16_bf16(a0, b1, acc[0][1], 0, 0, 0);
  acc[0][2] = __builtin_amdgcn_mfma_f32_32x32x16_bf16(a0, b2, acc[0][2], 0, 0, 0); acc[0][3] = __builtin_amdgcn_mfma_f32_32x32x16_bf16(a0, b3, acc[0][3], 0, 0, 0);
  acc[1][0] = __builtin_amdgcn_mfma_f32_32x32x16_bf16(a1, b0, acc[1][0], 0, 0, 0); acc[1][1] = __builtin_amdgcn_mfma_f32_32x32x16_bf16(a1, b1, acc[1][1], 0, 0, 0);
  acc[1][2] = __builtin_amdgcn_mfma_f32_32x32x16_bf16(a1, b2, acc[1][2], 0, 0, 0); acc[1][3] = __builtin_amdgcn_mfma_f32_32x32x16_bf16(a1, b3, acc[1][3], 0, 0, 0);
}
__device__ __forceinline__ void unitA(const bf16* __restrict__ Kc, const bf16* __restrict__ Vc, float* __restrict__ UT, char* lds) {
  int tid = threadIdx.x; asm volatile("" : "+v"(tid));
  const int wid = tid >> 6, lane = tid & 63, r32 = lane & 31, hi = lane >> 5, wr = wid >> 1, wc = wid & 1;
  f32x16 acc[2][4] = {};
  const int vbase = (int)(uintptr_t)lds + v_rd_base(lane);
  const int vbK = vbase + wc * IMG;
  const int vbV = vbase + 2 * IMG + (wr >> 1) * IMG + (wr & 1) * 1024;
  bf16x8 kr[4], vr[4];
  tile_load(kr, Kc, NIN, tid); tile_load(vr, Vc, NIN, tid);
  __syncthreads();
  tile_write<true>(kr, lds, tid); tile_write<true>(vr, lds + 2 * IMG, tid);
  __syncthreads();
#pragma unroll
  for (int tt = 0; tt < 4; ++tt) {
    if (tt < 3) { tile_load(kr, Kc + (size_t)(tt + 1) * 64 * NIN, NIN, tid); tile_load(vr, Vc + (size_t)(tt + 1) * 64 * NIN, NIN, tid); }
    passA_step<0>(acc, vbV, vbK); passA_step<1>(acc, vbV, vbK); passA_step<2>(acc, vbV, vbK); passA_step<3>(acc, vbV, vbK);
    if (tt < 3) { __syncthreads(); tile_write<true>(kr, lds, tid); tile_write<true>(vr, lds + 2 * IMG, tid); __syncthreads(); }
  }
#pragma unroll
  for (int a = 0; a < 2; ++a)
#pragma unroll
    for (int bb = 0; bb < 4; ++bb)
#pragma unroll
      for (int r = 0; r < 16; ++r) UT[(size_t)(64 * wr + 32 * a + crow(r, hi)) * 256 + 128 * wc + 32 * bb + r32] = acc[a][bb][r];
}
constexpr int KP = 528, KPAD_BYTES = 64 * KP;
__device__ __forceinline__ void rows_load(bf16x8 (&v)[4], const bf16* __restrict__ src, size_t pitch, int tid) {
  const int sr = tid >> 5, sc = (tid & 31) * 8;
#pragma unroll
  for (int i = 0; i < 4; ++i) v[i] = *reinterpret_cast<const bf16x8*>(src + (size_t)(sr + 16 * i) * pitch + sc);
}
__device__ __forceinline__ void rows_write(const bf16x8 (&v)[4], char* dst, int tid) {
  const int sr = tid >> 5, sc = (tid & 31) * 8;
#pragma unroll
  for (int i = 0; i < 4; ++i) *reinterpret_cast<bf16x8*>(dst + (sr + 16 * i) * KP + sc * 2) = v[i];
}
__device__ __forceinline__ void qkt256(f32x16& p0, f32x16& p1, const char* Kl, const char* Qs) {
  p0 = f32x16{}; p1 = f32x16{};
#pragma unroll
  for (int ks = 0; ks < 16; ++ks) {
    const bf16x8 b0 = *reinterpret_cast<const bf16x8*>(Kl + ks * 32);
    const bf16x8 b1 = *reinterpret_cast<const bf16x8*>(Kl + 32 * KP + ks * 32);
    const bf16x8 q = *reinterpret_cast<const bf16x8*>(Qs + ks * 1024);
    p0 = __builtin_amdgcn_mfma_f32_32x32x16_bf16(b0, q, p0, 0, 0, 0);
    p1 = __builtin_amdgcn_mfma_f32_32x32x16_bf16(b1, q, p1, 0, 0, 0);
    if ((ks & 3) == 3) SBA_SBAR(); }
}
__device__ __forceinline__ void cross_mma(f32x16& oi, const char* Sl, const char* Qs) {
#pragma unroll
  for (int ks = 0; ks < 16; ++ks) {
    const bf16x8 bfr = *reinterpret_cast<const bf16x8*>(Sl + ks * 32);
    const bf16x8 q = *reinterpret_cast<const bf16x8*>(Qs + ks * 1024);
    oi = __builtin_amdgcn_mfma_f32_32x32x16_bf16(q, bfr, oi, 0, 0, 0);
    if ((ks & 3) == 3) SBA_SBAR(); }
}
constexpr int R1_OFF = 65536, R2_OFF = 65536 + KPAD_BYTES;
__device__ __forceinline__ void unitC(const bf16* __restrict__ Qc, const bf16* __restrict__ Kc, const bf16* __restrict__ Vc, const bf16* __restrict__ Gc, const bf16* __restrict__ ST, bool has_state,
                                      const float* __restrict__ gn, bf16* __restrict__ Mc, int r0, char* lds) {
  int tid = threadIdx.x; asm volatile("" : "+v"(tid));
  const int wid = tid >> 6, lane = tid & 63, r32 = lane & 31, hi = lane >> 5, rg = wid & 3, dh = wid >> 2;
  f32x16 o[4] = {};
  const int qrow0 = r0 + 32 * rg;
  char* Qs = lds + rg * 16384 + lane * 16;
  const char* Kl = lds + R1_OFF + r32 * KP + hi * 16;
  const char* Sl1 = lds + R1_OFF + (dh * 32 + r32) * KP + hi * 16;
  const char* Sl2 = lds + R2_OFF + (dh * 32 + r32) * KP + hi * 16;
  const int vb0 = (int)(uintptr_t)lds + R2_OFF + v_rd_base(lane) + dh * 512;
  const int ntile = (r0 + 128) / 64;
  bf16x8 sa[4], sb[4];
  unsigned offK[4], offS[4], offV[4];
#pragma unroll
  for (int i = 0; i < 4; ++i) { offK[i] = (unsigned)(((tid >> 5) + 16 * i) * NIN + (tid & 31) * 8) * 2u; offS[i] = (unsigned)(((tid >> 5) + 16 * i) * 256 + (tid & 31) * 8) * 2u;
    offV[i] = (unsigned)(((tid >> 4) + 32 * (i & 1)) * NIN + (i >> 1) * 128 + (tid & 15) * 8) * 2u; }
#define RC_LD(dst, base, off) do { _Pragma("unroll") for (int i_ = 0; i_ < 4; ++i_) dst[i_] = *reinterpret_cast<const bf16x8*>(reinterpret_cast<const char*>(base) + (off)[i_]); } while (0)
  if (has_state) { RC_LD(sa, ST, offS); RC_LD(sb, ST + (size_t)64 * 256, offS); }
  else { RC_LD(sa, Kc, offK); RC_LD(sb, Vc, offV); }
  bf16x8 qv[8];
  { const bf16* Qw = Qc + (size_t)(qrow0 + r32) * NIN + hi * 8 + dh * 128;
#pragma unroll
    for (int k8 = 0; k8 < 8; ++k8) qv[k8] = *reinterpret_cast<const bf16x8*>(Qw + k8 * 16); }
  __syncthreads();
#pragma unroll
  for (int k8 = 0; k8 < 8; ++k8) *reinterpret_cast<bf16x8*>(Qs + (dh * 8 + k8) * 1024) = qv[k8];
  rows_write(sa, lds + R1_OFF, tid);
  if (has_state) rows_write(sb, lds + R2_OFF, tid); else tile_write<true>(sb, lds + R2_OFF, tid);
  __syncthreads();
  if (has_state) {
    RC_LD(sa, ST + (size_t)128 * 256, offS); RC_LD(sb, ST + (size_t)192 * 256, offS);
    cross_mma(o[0], Sl1, Qs); cross_mma(o[1], Sl2, Qs);
    __syncthreads(); rows_write(sa, lds + R1_OFF, tid); rows_write(sb, lds + R2_OFF, tid); __syncthreads();
    RC_LD(sa, Kc, offK); RC_LD(sb, Vc, offV);
    cross_mma(o[2], Sl1, Qs); cross_mma(o[3], Sl2, Qs);
    __syncthreads(); rows_write(sa, lds + R1_OFF, tid); tile_write<true>(sb, lds + R2_OFF, tid); __syncthreads();
  }
  for (int kt = 0; kt < ntile; ++kt) {
    const int k0 = kt * 64;
    if (kt + 1 < ntile) { RC_LD(sa, Kc + (size_t)(k0 + 64) * NIN, offK); RC_LD(sb, Vc + (size_t)(k0 + 64) * NIN, offV); }
    if (k0 <= qrow0 + 31) {
      f32x16 p0, p1; bf16x8 pa0, pa1, pa2, pa3;
      qkt256(p0, p1, Kl, Qs);
      if (k0 + 63 > qrow0) {
        const int lim = qrow0 + r32 - k0 + 1;
#pragma unroll
        for (int r = 0; r < 16; ++r) { p0[r] = (crow(r, hi) < lim) ? p0[r] : 0.f; p1[r] = (32 + crow(r, hi) < lim) ? p1[r] : 0.f; }
      }
      sba::pack_p(p0, p1, pa0, pa1, pa2, pa3);
      sba::pv_one<0>(o[0], vb0, pa0, pa1, pa2, pa3); sba::pv_one<2>(o[1], vb0, pa0, pa1, pa2, pa3);
      sba::pv_one<0>(o[2], vb0 + IMG, pa0, pa1, pa2, pa3); sba::pv_one<2>(o[3], vb0 + IMG, pa0, pa1, pa2, pa3);
    }
    __syncthreads();
    if (kt + 1 < ntile) { rows_write(sa, lds + R1_OFF, tid); tile_write<true>(sb, lds + R2_OFF, tid); __syncthreads(); }
  }
  int le = lane; asm volatile("" : "+v"(le));
  v2u gwv[16];
#pragma unroll
  for (int rr = 0; rr < 16; ++rr) gwv[rr] = *(const v2u*)(Gc + (size_t)(r0 + wid * 16 + rr) * NIN + le * 4);
  const f32x4 gg = *(const f32x4*)(gn + le * 4);
  float* Ol = (float*)lds;
#pragma unroll
  for (int i = 0; i < 4; ++i)
#pragma unroll
    for (int r = 0; r < 16; ++r) Ol[(32 * rg + crow(r, hi)) * 256 + (2 * i + dh) * 32 + r32] = o[i][r];
  __syncthreads();
#pragma unroll
  for (int rr = 0; rr < 16; ++rr) {
    const int row = wid * 16 + rr;
    const f32x4 v = *(const f32x4*)(Ol + row * 256 + le * 4);
    const float mu = wave_sum((v.x + v.y) + (v.z + v.w)) * (1.f / 256.f);
    const f32x4 d = v - mu;
    const float var = wave_sum((d.x * d.x + d.y * d.y) + (d.z * d.z + d.w * d.w)) * (1.f / 256.f);
    const float rstd = 1.0f / sqrtf(var + EPS);
    const v2u gw = gwv[rr];
    const f32x4 y = d * rstd * gg * (f32x4){bf_lo(gw.x), bf_hi(gw.x), bf_lo(gw.y), bf_hi(gw.y)};
    v2u ow; ow.x = pk2(y.x, y.y); ow.y = pk2(y.z, y.w);
    *(v2u*)(Mc + (size_t)(r0 + row) * D + le * 4) = ow;
  }
#undef RC_LD
}
}

__device__ __forceinline__ void ret_passA_phase(Frame& F) {
  for (int u = blockIdx.x; u < 16 * 32; u += F.G) {
    const int bh = u >> 5, c = u & 31, b = bh >> 3, h = bh & 7;
    const bf16* base = F.PROJ + ((size_t)b * T + (size_t)c * 256) * NIN + h * RD;
    ret::unitA(base + C_RK, base + C_RV, F.UT + (size_t)u * 65536, (char*)F.lds);
  }
  __syncthreads();
}
__device__ __forceinline__ void ret_scan_phase(Frame& F) {
  const int gt = (F.vcu * NWAVES + F.wave) * 64 + F.lane, NT_ = F.G * NWAVES * 64;
  for (int e = gt; e < 16 * 16384; e += NT_) {
    const int bh = e >> 14, q = e & 16383, h = bh & 7;
    const float gC = __builtin_amdgcn_exp2f(c_log2g[h] * 256.f);
    const float* up = F.UT + (size_t)bh * 32 * 65536 + q * 4;
    bf16* sp = F.ST + (size_t)bh * 32 * 65536 + q * 4;
    f32x4 uv[31];
#pragma unroll
    for (int c = 0; c < 31; ++c) uv[c] = *(const GAS f32x4*)(up + (size_t)c * 65536);
    f32x4 s = (f32x4){0.f, 0.f, 0.f, 0.f};
#pragma unroll
    for (int c = 0; c < 32; ++c) {
      v2u w; w.x = pk2(s.x, s.y); w.y = pk2(s.z, s.w);
      *(GAS v2u*)(sp + (size_t)c * 65536) = w;
      if (c < 31) s = (s + uv[c]) * gC;
    }
  }
}
__device__ __forceinline__ void ret_passC_phase(Frame& F) {
  for (int u = blockIdx.x; u < 16 * 32; u += F.G) {
    const int bh = u >> 5, c = u & 31, b = bh >> 3, h = bh & 7;
    const size_t tok0 = (size_t)b * T + (size_t)c * 256;
    const bf16* base = F.PROJ + tok0 * NIN + h * RD;
    const bf16* ST = F.ST + (size_t)u * 65536;
    bf16* Mc = F.MIX + tok0 * D + 2048 + h * RD;
    ret::unitC(base + C_RQ, base + C_RK, base + C_RV, base + C_RG, ST, c != 0, F.g_ret + h * RD, Mc, 0, (char*)F.lds);
    ret::unitC(base + C_RQ, base + C_RK, base + C_RV, base + C_RG, ST, c != 0, F.g_ret + h * RD, Mc, 128, (char*)F.lds);
  }
  __syncthreads();
}

struct Args { const float* in[10]; float* out; unsigned char* ws; int ph_lo, ph_hi, li, pad; };
__global__ void __launch_bounds__(NWAVES * 64, 2) hymba_fwd(Args args) {
    extern __shared__ __attribute__((aligned(16))) unsigned char lds[];
    Frame F;
    F.lds = (LAS unsigned char*)lds;
    F.MISC = (volatile LAS unsigned*)(F.lds + MISC_OFF);
    F.tid = threadIdx.x; F.lane = F.tid & 63; F.wave = __builtin_amdgcn_readfirstlane(F.tid >> 6);
    F.G = gridDim.x; { const int bx = blockIdx.x; F.vcu = (F.G % 8 == 0) ? (bx % 8) * (F.G / 8) + bx / 8 : bx; }
    unsigned char* ws = args.ws;
    F.ctl = (gu32*)(ws + WS_CTL);
    F.x = args.in[0]; F.g_attn = args.in[1]; F.w_in = args.in[2]; F.g_sb = args.in[3]; F.g_ret = args.in[4]; F.w_out = args.in[5];
    F.g_mlp = args.in[6]; F.w_up = args.in[7]; F.w_down = args.in[8]; F.g_fin = args.in[9]; F.out = args.out;
    F.XN = (bf16*)(ws + WS_XN); F.WIN = (bf16*)(ws + WS_WIN); F.WOUT = (bf16*)(ws + WS_WOUT); F.PROJ = (bf16*)(ws + WS_PROJ); F.MIX = (bf16*)(ws + WS_MIX);
    F.WUP = (bf16*)args.out; F.HID = (bf16*)(ws + WS_HID); F.WDOWN = (bf16*)args.out + (size_t)FF * D;
    F.SBO = (float*)(ws + WS_XN); F.ROPE = (float*)(ws + WS_ROPE); F.UT = (float*)(ws + WS_WIN); F.ST = (bf16*)(ws + WS_STATE); F.ATT = (bf16*)(ws + WS_ATT); F.MLP = (bf16*)(ws + WS_MLP); F.PART1 = (float*)(ws + WS_PART1); F.PARTSB = (float*)(ws + WS_PART1 + 4 * MiB); F.RSTDX = (float*)(ws + WS_PART1 + 5 * MiB);
    for (int u = F.tid; u < (LDS_BYTES - LDSCTL_OFF) / 4; u += NWAVES * 64) ((LAS unsigned*)(F.lds + LDSCTL_OFF))[u] = 0u;
    __syncthreads();
    XcdBarrier bar; bar.bar = (unsigned*)(F.ctl + CW_BAR); bar.x = 0; bar.st = nullptr;
    if (N_LAUNCHES != PER_PHASE) bar = xcd_barrier_post((unsigned*)(F.ctl + CW_BAR) + args.li * XCD_BAR_WORDS, F.MISC + 8);
#define GRID_BAR(seam) do { if (N_LAUNCHES == PER_PHASE) { if (F.tid == 0) __hip_atomic_store(F.ctl + CW_TMO, 0xBADBA0u | (unsigned)(seam), RLX_AGENT); } \
    else { xcd_barrier(bar); } } while (0)
    const int lo = args.ph_lo, hi = args.ph_hi;
#define IN(k) (lo <= (k) && (k) < hi)
#define BOTH(k) (IN(k) && IN((k) + 1))
    const int gw = F.vcu * NWAVES + F.wave, NGW = F.G * NWAVES;

    if (IN(0)) { p0_prologue(F); if (BOTH(0)) GRID_BAR(0); }
    if (IN(1)) {
        pg8::Gemm g{F.XN, F.WIN, M, NIN, D}; pg8::StaticOrder S; S.init(M, NIN, F.G, (int)blockIdx.x, WGM_P1);
        LAS float* tabx = (LAS float*)(F.lds + LDSCTL_OFF + 1024);
        { pg8::Unit u0, ui_; bool okpm = S.next(0, u0); for (int i = 1; S.next(i, ui_); ++i) okpm = okpm && (ui_.pm == u0.pm);
          if (F.tid < 256) tabx[F.tid] = okpm ? F.RSTDX[(size_t)u0.pm * 256 + F.tid] : __builtin_nanf("");
          __syncthreads(); }
        EpiProj E{F.PROJ, F.ROPE, tabx};
        pg8::gemm_phase<EpiProj, pg8::StaticOrder, GEMM_ALIGN, GEMM_SP2>(F.lds + RING_OFF, g, S, E);
        if (BOTH(1)) GRID_BAR(1);
    }
    if (IN(2)) { ret_passA_phase(F); if (BOTH(2)) GRID_BAR(2); }
    if (IN(3)) { ret_scan_phase(F); if (BOTH(3)) GRID_BAR(3); }
    if (IN(4)) { sb_fast_phase(F); ret_passC_phase(F); if (BOTH(4)) GRID_BAR(4); }
    if (IN(5)) { }
    if (IN(6)) {
        pg8::Gemm g{F.MIX, F.WOUT, M, D, D}; pg8::StaticOrder S; S.init(M, D, F.G, (int)blockIdx.x, WGM_P6);
        EpiX1 E{F.XN, F.ATT, F.PART1, D};
        LAS float* tabsb = (LAS float*)(F.lds + LDSCTL_OFF + 3072);
        { pg8::Unit u0, ui_; bool okpm = S.next(0, u0); for (int i = 1; S.next(i, ui_); ++i) okpm = okpm && (ui_.pm == u0.pm);
          const int row = F.tid >> 1, half = F.tid & 1;
          const GAS f32x4* pp = (const GAS f32x4*)(F.PARTSB + ((size_t)u0.pm * 256 + row) * 16 + half * 8);
          const f32x4 t0 = pp[0], t1 = pp[1]; float s = ((t0.x + t0.y) + (t0.z + t0.w)) + ((t1.x + t1.y) + (t1.z + t1.w));
          s += __shfl_xor(s, 1);
          if (half == 0) tabsb[row] = okpm ? 1.0f / sqrtf(s * (1.f / 2048.f) + EPS) : __builtin_nanf("");
          __syncthreads(); }
        ScaleRowsAt KH{2048 / 64, tabsb};
        pg8::gemm_phase<EpiX1, pg8::StaticOrder, GEMM_ALIGN, GEMM_SP2, ScaleRowsAt>(F.lds + RING_OFF, g, S, E, KH);
        if (BOTH(6)) GRID_BAR(6);
    }
    if (IN(7)) { }
    if (IN(8)) {
        pg8::Gemm g{F.ATT, F.WUP, M, FF, D}; pg8::StaticOrder S; S.init(M, FF, F.G, (int)blockIdx.x, WGM_P8);
        LAS float* tab = (LAS float*)(F.lds + LDSCTL_OFF + 2048);
        { pg8::Unit u0, ui_; bool okpm = S.next(0, u0); for (int i = 1; S.next(i, ui_); ++i) okpm = okpm && (ui_.pm == u0.pm);
          const int row = F.tid >> 1, half = F.tid & 1;
          const GAS f32x4* pp = (const GAS f32x4*)(F.PART1 + ((size_t)u0.pm * 256 + row) * 64 + half * 32);
          float s = 0.f;
#pragma unroll
          for (int j = 0; j < 8; ++j) { const f32x4 t = pp[j]; s += (t.x + t.y) + (t.z + t.w); }
          s += __shfl_xor(s, 1);
          if (half == 0) tab[row] = okpm ? 1.0f / sqrtf(s * (1.f / 4096.f) + EPS) : __builtin_nanf("");
          __syncthreads(); }
        EpiRelu2S E{F.HID, FF, tab};
        pg8::gemm_phase<EpiRelu2S, pg8::StaticOrder, GEMM_ALIGN, GEMM_SP2>(F.lds + RING_OFF, g, S, E);
        if (BOTH(8)) GRID_BAR(8);
    }
    if (IN(9)) { }
    if (IN(10)) {
        pg8::Gemm g{F.HID, F.WDOWN, M, D, FF}; pg8::StaticOrder S; S.init(M, D, F.G, (int)blockIdx.x, WGM_P9);
        EpiBf16 E{F.MLP, D};
        pg8::gemm_phase<EpiBf16, pg8::StaticOrder, GEMM_ALIGN, GEMM_SP2>(F.lds + RING_OFF, g, S, E);
        if (BOTH(10)) GRID_BAR(10);
    }
    if (IN(11)) {
        for (int m = gw; m < M; m += NGW) rms_row_bb(F.ATT + (size_t)m * D, F.MLP + (size_t)m * D, F.g_fin, F.out + (size_t)m * D, F.lane);

    }
#undef IN
#undef BOTH
}

extern "C" void kernel_launch(void* const* d_in, const int* in_sizes, int n_in, void* d_out, int out_size, void* d_ws, size_t ws_size, hipStream_t stream) {
    static int grid = 0;
    if (grid == 0) {
        if (n_in != 10 || in_sizes[0] != M * D || out_size != M * D || ws_size < WS_END) { fprintf(stderr, "kernel_launch: shape/workspace mismatch (ws %zu, need %zu)\n", ws_size, (size_t)WS_END); grid = -1; return; }
        int dev = 0, cus = 0, per_cu = 0;
        if (hipGetDevice(&dev) != hipSuccess || hipDeviceGetAttribute(&cus, hipDeviceAttributeMultiprocessorCount, dev) != hipSuccess) { grid = -1; return; }
        if (hipFuncSetAttribute((const void*)hymba_fwd, hipFuncAttributeMaxDynamicSharedMemorySize, LDS_BYTES) != hipSuccess) { fprintf(stderr, "kernel_launch: hipFuncSetAttribute failed\n"); grid = -1; return; }
        if (hipOccupancyMaxActiveBlocksPerMultiprocessor(&per_cu, (const void*)hymba_fwd, NWAVES * 64, LDS_BYTES) != hipSuccess || per_cu < 1)
            fprintf(stderr, "kernel_launch: occupancy query reports %d workgroups per CU\n", per_cu);
        (void)hipGetLastError();
        grid = cus;
    }
    if (grid < 0) return;
    if (hipMemsetAsync((char*)d_ws + WS_CTL, 0, CTL_ZERO_BYTES, stream) != hipSuccess) return;
    Args a{};
    for (int i = 0; i < 10; ++i) a.in[i] = (const float*)d_in[i];
    a.out = (float*)d_out; a.ws = (unsigned char*)d_ws;
    if (N_LAUNCHES == 1) {
        a.ph_lo = 0; a.ph_hi = PER_PHASE; a.li = 0;
        hipLaunchKernelGGL(hymba_fwd, dim3(grid), dim3(NWAVES * 64), LDS_BYTES, stream, a);
    } else {
        for (int li = 0; li < PER_PHASE; ++li) {
            a.ph_lo = li; a.ph_hi = li + 1; a.li = 0;
            hipLaunchKernelGGL(hymba_fwd, dim3(grid), dim3(NWAVES * 64), LDS_BYTES, stream, a);
        }
    }
    const hipError_t le = hipPeekAtLastError();
    if (le != hipSuccess) fprintf(stderr, "kernel_launch: launch failed: %s\n", hipGetErrorName(le));
}
```

```cpp
#include <hip/hip_runtime.h>
#include <cstdio>
#include <cstdint>

namespace pg8 {
#define PG8_LAS __attribute__((address_space(3)))
typedef unsigned short bf16_t;
typedef short bf16x8 __attribute__((ext_vector_type(8)));
typedef float f32x4 __attribute__((ext_vector_type(4)));
typedef unsigned u32x4 __attribute__((ext_vector_type(4)));
constexpr int BM = 256, BK = 64, HALF = 128, HTB = HALF * BK * 2, STAGE_BYTES = 8 * HTB, NXCD = 8, WGM = 8;

__host__ __device__ __forceinline__ int lds_byte(int r, int c) { const int st = (r >> 4) * 2 + (c >> 5), rr = r & 15, cc = c & 31, ob = rr * 64 + cc * 2; return st * 1024 + (ob ^ (((ob >> 9) & 1) << 5)); }
__host__ __device__ __forceinline__ void stage_rc(int b, int& R, int& C) { const int st = b / 1024, sb = b % 1024, swz = sb ^ (((sb >> 9) & 1) << 5); R = (st >> 1) * 16 + swz / 64; C = (st & 1) * 32 + (swz % 64) / 2; }
__host__ __device__ __forceinline__ int perm32(int rho) { const int n = rho >> 4, i = rho & 15; return 8 * (i >> 2) + 4 * n + (i & 3); }

struct Unit { int pm, pn; };
struct Gemm { const bf16_t* A; const bf16_t* Bt; int M, N, K; };

struct StaticOrder {
    int nM, nN, nwg, G, c, wgm;
    __host__ __device__ void init(int M, int N, int G_, int c_, int wgm_ = WGM) { nM = M / BM; nN = N / BM; nwg = nM * nN; G = G_; c = c_; wgm = wgm_; }
    __host__ __device__ bool next(int i, Unit& u) const {
        const long L = (long)i * G + c; if (L >= nwg) return false;
        int wgid = (int)L; { const int q = nwg / NXCD, r = nwg % NXCD, xcd = wgid % NXCD, off = wgid / NXCD; wgid = (xcd < r ? xcd * (q + 1) : r * (q + 1) + (xcd - r) * q) + off; }
        const int nig = wgm * nN, gid = wgid / nig, fm = gid * wgm, gsz = (nM - fm) < wgm ? (nM - fm) : wgm;
        u.pm = fm + ((wgid % nig) % gsz); u.pn = (wgid % nig) / gsz; return true;
    }
    __device__ __forceinline__ void a_ready(const Unit&) const {}
    __device__ __forceinline__ void done(const Unit&) const {}
};

__device__ __forceinline__ unsigned cvt_pk_bf16(float lo, float hi) { unsigned r; asm volatile("v_cvt_pk_bf16_f32 %0, %1, %2" : "=v"(r) : "v"(lo), "v"(hi)); return r; }

struct NoKHook { static constexpr bool ACTIVE = false; __device__ __forceinline__ void operator()(int, f32x4 (&)[2][2][4][2], int, int) const {} };
template <class Epi, class Sched, bool ALIGN_EPI = false, bool SP2 = false, class KHook = NoKHook>
__device__ __forceinline__ void gemm_phase(PG8_LAS unsigned char* lds, const Gemm g, const Sched& S, const Epi& E, const KHook& KH = KHook()) {
    const int tid = threadIdx.x, wid = __builtin_amdgcn_readfirstlane(tid >> 6), lane = tid & 63, wr = wid >> 2, wc = wid & 3, fr = lane & 15, fq = lane >> 4;
    const int K = g.K, nt = K / BK;
    unsigned voffA[2], voffB[2];
#pragma unroll
    for (int i = 0; i < 2; ++i) { int R, C; stage_rc(tid * 16 + i * 8192, R, C); const int Rb = Epi::PERM ? ((R & ~31) + perm32(R & 31)) : R;
        voffA[i] = (unsigned)(R * K + C) * 2u; voffB[i] = (unsigned)(Rb * K + C) * 2u; }
    const size_t kstep = (size_t)(BK * 2);
    const size_t hstep = (size_t)HALF * K * 2;
    const size_t tstep = 2 * hstep;
    const unsigned ldsw = (unsigned)wid * 1024u;
    const int aoff = lds_byte(wr * 64 + fr, fq * 8), boff = lds_byte(wc * 32 + fr, fq * 8);
#define PG8_SA(b, h) (((b) * 2 + (h)) * HTB)
#define PG8_SB(b, h) ((4 + (b) * 2 + (h)) * HTB)
#define PG8_STAGE(bufoff, gbase, voff) do { _Pragma("unroll") for (int _i = 0; _i < 2; ++_i) \
        __builtin_amdgcn_global_load_lds((const unsigned*)((const char*)(gbase) + (voff)[_i]), (PG8_LAS unsigned*)(lds + (bufoff) + ldsw + _i * 8192), 16, 0, 0); } while (0)
#define PG8_LDA(dst, b, h) do { _Pragma("unroll") for (int m = 0; m < 4; ++m) _Pragma("unroll") for (int k = 0; k < 2; ++k) dst[m][k] = *(const PG8_LAS bf16x8*)(lds + PG8_SA(b, h) + aoff + m * 2048 + k * 1024); } while (0)
#define PG8_LDB(dst, b, h) do { _Pragma("unroll") for (int n = 0; n < 2; ++n) _Pragma("unroll") for (int k = 0; k < 2; ++k) dst[n][k] = *(const PG8_LAS bf16x8*)(lds + PG8_SB(b, h) + boff + n * 2048 + k * 1024); } while (0)
#define PG8_MMA(ai, bj, At, Bt) do { __builtin_amdgcn_s_setprio(1); _Pragma("unroll") for (int m = 0; m < 4; ++m) _Pragma("unroll") for (int n = 0; n < 2; ++n) _Pragma("unroll") for (int k = 0; k < 2; ++k) \
        acc[ai][bj][m][n] = __builtin_amdgcn_mfma_f32_16x16x32_bf16(Bt[n][k], At[m][k], acc[ai][bj][m][n], 0, 0, 0); __builtin_amdgcn_s_setprio(0); } while (0)
#define PG8_WAIT_V(n) asm volatile("s_waitcnt vmcnt(" #n ")" ::: "memory")
#define PG8_WAIT_L(n) asm volatile("s_waitcnt lgkmcnt(" #n ")" ::: "memory")
#define PG8_BAR __builtin_amdgcn_s_barrier()
#define PG8_SCHED __builtin_amdgcn_sched_barrier(0)
    Unit cur, nxt; int ui = 0;
    if (!S.next(0, cur)) return;
    f32x4 acc[2][2][4][2];
#pragma unroll
    for (int a = 0; a < 2; ++a)
#pragma unroll
        for (int b = 0; b < 2; ++b)
#pragma unroll
            for (int m = 0; m < 4; ++m)
#pragma unroll
                for (int n = 0; n < 2; ++n) acc[a][b][m][n] = (f32x4){0.f, 0.f, 0.f, 0.f};
    bf16x8 At[4][2], B0[2][2], B1[2][2];
    const char* cA = (const char*)g.A + (size_t)cur.pm * tstep; const char* cB = (const char*)g.Bt + (size_t)cur.pn * tstep;
    S.a_ready(cur);
    if constexpr (SP2) {
        PG8_STAGE(PG8_SB(0, 0), cB, voffB); PG8_STAGE(PG8_SB(0, 1), cB + hstep, voffB); PG8_STAGE(PG8_SA(0, 0), cA, voffA); PG8_STAGE(PG8_SA(0, 1), cA + hstep, voffA);
        if (wr == 1) PG8_BAR;
        PG8_WAIT_V(2); PG8_BAR;
        PG8_STAGE(PG8_SB(1, 0), cB + kstep, voffB); PG8_STAGE(PG8_SA(1, 0), cA + kstep, voffA); PG8_STAGE(PG8_SB(1, 1), cB + hstep + kstep, voffB);
        PG8_WAIT_V(6); PG8_BAR;
    } else {
        PG8_STAGE(PG8_SB(0, 0), cB, voffB); PG8_STAGE(PG8_SA(0, 0), cA, voffA); PG8_STAGE(PG8_SB(0, 1), cB + hstep, voffB); PG8_STAGE(PG8_SA(0, 1), cA + hstep, voffA);
        if (wr == 1) PG8_BAR;
        PG8_WAIT_V(4); PG8_BAR;
        PG8_STAGE(PG8_SB(1, 0), cB + kstep, voffB); PG8_STAGE(PG8_SA(1, 0), cA + kstep, voffA); PG8_STAGE(PG8_SB(1, 1), cB + hstep + kstep, voffB);
        PG8_WAIT_V(6); PG8_BAR;
    }
    for (;;) {
        const bool has_next = S.next(ui + 1, nxt);
        const char* nA = has_next ? (const char*)g.A + (size_t)nxt.pm * tstep : cA; const char* nB = has_next ? (const char*)g.Bt + (size_t)nxt.pn * tstep : cB;
        for (int t = 0; t < nt; t += 2) {
            const bool last = (t == nt - 2);
            const char* a1 = cA + (size_t)(t + 1) * kstep;
            const char* a2 = last ? nA : cA + (size_t)(t + 2) * kstep; const char* b2 = last ? nB : cB + (size_t)(t + 2) * kstep;
            const char* a3 = a2 + kstep; const char* b3 = b2 + kstep;
            if (last && has_next) S.a_ready(nxt);
            if constexpr (KHook::ACTIVE) KH(t, acc, wr, fr);
            if constexpr (SP2) {
            PG8_LDB(B0, 0, 0); PG8_LDB(B1, 0, 1); PG8_SCHED; PG8_LDA(At, 0, 0); PG8_STAGE(PG8_SA(1, 1), a1 + hstep, voffA);
            PG8_WAIT_V(8); PG8_WAIT_L(0); PG8_BAR; PG8_MMA(0, 0, At, B0); PG8_MMA(0, 1, At, B1); PG8_BAR; PG8_SCHED;
            PG8_LDA(At, 0, 1); PG8_STAGE(PG8_SB(0, 0), b2, voffB); PG8_STAGE(PG8_SB(0, 1), b2 + hstep, voffB); PG8_STAGE(PG8_SA(0, 0), a2, voffA);
            PG8_WAIT_V(8); PG8_WAIT_L(0); PG8_BAR; PG8_MMA(1, 0, At, B0); PG8_MMA(1, 1, At, B1); PG8_BAR; PG8_SCHED;
            PG8_LDB(B0, 1, 0); PG8_LDB(B1, 1, 1); PG8_SCHED; PG8_LDA(At, 1, 0); PG8_STAGE(PG8_SA(0, 1), a2 + hstep, voffA);
            PG8_WAIT_V(8); PG8_WAIT_L(0); PG8_BAR; PG8_MMA(0, 0, At, B0); PG8_MMA(0, 1, At, B1); PG8_BAR; PG8_SCHED;
            PG8_LDA(At, 1, 1); PG8_STAGE(PG8_SB(1, 0), b3, voffB); PG8_STAGE(PG8_SB(1, 1), b3 + hstep, voffB); PG8_STAGE(PG8_SA(1, 0), a3, voffA);
            PG8_WAIT_V(8); PG8_WAIT_L(0); PG8_BAR; PG8_MMA(1, 0, At, B0); PG8_MMA(1, 1, At, B1); PG8_BAR; PG8_SCHED;
            } else {
            PG8_LDB(B0, 0, 0); PG8_SCHED; PG8_LDA(At, 0, 0); PG8_STAGE(PG8_SA(1, 1), a1 + hstep, voffA);
            PG8_WAIT_L(8); PG8_BAR; PG8_WAIT_L(0); PG8_MMA(0, 0, At, B0); PG8_BAR; PG8_SCHED;
            PG8_LDB(B1, 0, 1); PG8_STAGE(PG8_SB(0, 0), b2, voffB);
            PG8_BAR; PG8_WAIT_L(0); PG8_MMA(0, 1, At, B1); PG8_BAR;
            PG8_LDA(At, 0, 1); PG8_STAGE(PG8_SA(0, 0), a2, voffA);
            PG8_BAR; PG8_WAIT_L(0); PG8_MMA(1, 0, At, B0); PG8_BAR; PG8_SCHED;
            PG8_STAGE(PG8_SB(0, 1), b2 + hstep, voffB);
            PG8_WAIT_V(6); PG8_BAR; PG8_MMA(1, 1, At, B1); PG8_BAR;
            PG8_LDB(B0, 1, 0); PG8_SCHED; PG8_LDA(At, 1, 0); PG8_STAGE(PG8_SA(0, 1), a2 + hstep, voffA);
            PG8_WAIT_L(8); PG8_BAR; PG8_WAIT_L(0); PG8_MMA(0, 0, At, B0); PG8_BAR; PG8_SCHED;
            PG8_LDB(B1, 1, 1); PG8_STAGE(PG8_SB(1, 0), b3, voffB);
            PG8_BAR; PG8_WAIT_L(0); PG8_MMA(0, 1, At, B1); PG8_BAR;
            PG8_LDA(At, 1, 1); PG8_STAGE(PG8_SA(1, 0), a3, voffA);
            PG8_BAR; PG8_WAIT_L(0); PG8_MMA(1, 0, At, B0); PG8_BAR; PG8_SCHED;
            PG8_STAGE(PG8_SB(1, 1), b3 + hstep, voffB);
            PG8_WAIT_V(6); PG8_BAR; PG8_MMA(1, 1, At, B1); PG8_BAR;
            }
        }
        if constexpr (ALIGN_EPI) { if (wr == 0) PG8_BAR; }
        E(acc, cur, wr, wc, fr, fq); S.done(cur);
        if (!has_next) break;
#pragma unroll
        for (int a = 0; a < 2; ++a)
#pragma unroll
            for (int b = 0; b < 2; ++b)
#pragma unroll
                for (int m = 0; m < 4; ++m)
#pragma unroll
                    for (int n = 0; n < 2; ++n) acc[a][b][m][n] = (f32x4){0.f, 0.f, 0.f, 0.f};
        cur = nxt; cA = nA; cB = nB; ++ui;
        if constexpr (ALIGN_EPI) { if (wr == 1) PG8_BAR; }
    }
    PG8_WAIT_V(0);
    if constexpr (!ALIGN_EPI) { if (wr == 0) PG8_BAR; }
    PG8_BAR;
#undef PG8_SA
#undef PG8_SB
#undef PG8_STAGE
#undef PG8_LDA
#undef PG8_LDB
#undef PG8_MMA
#undef PG8_WAIT_V
#undef PG8_WAIT_L
#undef PG8_BAR
#undef PG8_SCHED
}
}

constexpr int NWAVES = 8;
#ifndef MK_N_LAUNCHES
#define MK_N_LAUNCHES 1
#endif
constexpr int PER_PHASE = 12;
constexpr int N_LAUNCHES = MK_N_LAUNCHES;
#ifndef DEFER_OUT
#define DEFER_OUT 1
#endif
#ifndef GROUP_TAIL
#define GROUP_TAIL 1
#endif
#ifndef DEFER_DOWN
#define DEFER_DOWN 1
#endif
#ifndef DEFER_UP
#define DEFER_UP 1
#endif
#ifndef WGM_P1
#define WGM_P1 8
#endif
#ifndef WGM_P6
#define WGM_P6 8
#endif
#ifndef WGM_P8
#define WGM_P8 8
#endif
#ifndef WGM_P9
#define WGM_P9 8
#endif
#ifndef GEMM_SP2
#define GEMM_SP2 true
#endif
#ifndef GEMM_ALIGN
#define GEMM_ALIGN true
#endif

constexpr int BATCH = 2, T = 8192, D = 4096, M = BATCH * T;
constexpr int SBH = 16, SBD = 128, RH = 8, RD = 256;
constexpr int NIN = 14336, FF = 16384;
constexpr int C_SBQ = 0, C_SBK = 2048, C_SBV = 4096, C_RQ = 6144, C_RK = 8192, C_RV = 10240, C_RG = 12288;
constexpr float EPS = 1e-6f;
constexpr float QSCALE = 0.12751743082459868f;

constexpr size_t MiB = 1u << 20;
constexpr size_t WS_CTL = 0, CTL_ZERO_BYTES = 1 * MiB;
constexpr size_t WS_XN = 1 * MiB;
constexpr size_t WS_WIN = 129 * MiB;
constexpr size_t WS_MIX = 129 * MiB;
constexpr size_t WS_MLP = 1 * MiB;
constexpr size_t WS_WOUT = 257 * MiB;
constexpr size_t WS_PROJ = 289 * MiB;
constexpr size_t WS_HID = 289 * MiB;
constexpr size_t WS_ROPE = 801 * MiB;
constexpr size_t WS_STATE = 809 * MiB;
constexpr size_t WS_ATT = 801 * MiB;
constexpr size_t WS_PART1 = 929 * MiB;
constexpr size_t WS_END = 935 * MiB;
constexpr int CW_TMO = 0, CW_CODE = 1, CW_BAR = 4096, CW_QUP = 32768, CW_QDN = 32832, CW_GRP = 33024, CW_ROWQ = 33792, CW_QOUT = 32896;

constexpr int RING_OFF = 0, RING_BYTES = 135168;
constexpr int LDSCTL_OFF = RING_BYTES, MISC_OFF = LDSCTL_OFF + 320;
constexpr int LDS_BYTES = 147456;

#define GAS __attribute__((address_space(1)))
#define LAS __attribute__((address_space(3)))
typedef unsigned short bf16;
typedef unsigned v4u __attribute__((ext_vector_type(4)));
typedef unsigned v2u __attribute__((ext_vector_type(2)));
typedef float f32x4 __attribute__((ext_vector_type(4)));
typedef GAS unsigned gu32;
#define RLX_AGENT __ATOMIC_RELAXED, __HIP_MEMORY_SCOPE_AGENT
#define LDS_WAIT() asm volatile("s_waitcnt lgkmcnt(0)" ::: "memory")
#define VM_WAIT() asm volatile("s_waitcnt vmcnt(0)" ::: "memory")
__device__ __forceinline__ unsigned f2bf(float f) { unsigned u = __builtin_bit_cast(unsigned, f); return (u + 0x7fffu + ((u >> 16) & 1u)) >> 16; }
__device__ __forceinline__ unsigned pk2(float lo, float hi) { return f2bf(lo) | (f2bf(hi) << 16); }
__device__ __forceinline__ float bf_lo(unsigned w) { return __builtin_bit_cast(float, w << 16); }
__device__ __forceinline__ float bf_hi(unsigned w) { return __builtin_bit_cast(float, w & 0xffff0000u); }

#define XB_TMO      128
#define XB_XCNT(j)  (256  + 64 * (j))
#define XB_XSUB(j)  (1280 + 64 * (j))
#define XB_XGEN(j)  (2304 + 64 * (j))
#define XB_TOP      3328
#define XB_TOPGEN   3392
#define XCD_BAR_WORDS 3456
#define XB_SPIN_CAP (1u << 18)

__device__ __forceinline__ unsigned xb_ld(unsigned* p)              { return __hip_atomic_load(p, __ATOMIC_RELAXED, __HIP_MEMORY_SCOPE_AGENT); }
__device__ __forceinline__ unsigned xb_add(unsigned* p, unsigned v) { return __hip_atomic_fetch_add(p, v, __ATOMIC_RELAXED, __HIP_MEMORY_SCOPE_AGENT); }
__device__ __forceinline__ unsigned xb_xcc_id() { return (unsigned)__builtin_amdgcn_s_getreg((3 << 11) | 20) & 0xFu; }
#define XB_SPIN(cond, bar) do { unsigned _sp = 0; while (cond) { __builtin_amdgcn_s_sleep(1); \
    if ((++_sp & 255u) == 0u) { if (xb_ld(&(bar)[XB_TMO])) break; if (_sp > XB_SPIN_CAP) { atomicAdd(&(bar)[XB_TMO], 1u); break; } } } } while (0)

struct XcdBarrier {
    unsigned* bar; unsigned x;
    volatile LAS unsigned* st;
};
__device__ __forceinline__ XcdBarrier xcd_barrier_post(unsigned* bar, volatile LAS unsigned* st) {
    XcdBarrier b; b.bar = bar; b.x = xb_xcc_id(); b.st = st;
    if (threadIdx.x == 0) (void)xb_add(&bar[XB_XCNT(b.x)], 1u);
    return b;
}
__device__ __forceinline__ void xcd_barrier_complete(unsigned* bar, unsigned x, unsigned& nloc, unsigned& nx) {
    const unsigned G = gridDim.x * gridDim.y * gridDim.z;
    unsigned sum, cnt, mine, sp = 0u;
    for (;;) {
        sum = 0u; cnt = 0u; mine = 0u;
#pragma unroll
        for (unsigned j = 0; j < 16; ++j) { const unsigned c = xb_ld(&bar[XB_XCNT(j)]); sum += c; cnt += (c > 0u) ? 1u : 0u; mine = (j == x) ? c : mine; }
        if (sum == G) break;
        __builtin_amdgcn_s_sleep(1);
        if ((++sp & 255u) == 0u) { if (xb_ld(&bar[XB_TMO])) break; if (sp > XB_SPIN_CAP) { atomicAdd(&bar[XB_TMO], 1u); break; } }
    }
    nloc = mine > 0u ? mine : 1u; nx = cnt > 0u ? cnt : 1u;
}
__device__ __forceinline__ void xcd_barrier(const XcdBarrier& b) {
    asm volatile("s_waitcnt vmcnt(0)" ::: "memory");
    __syncthreads();
    if (threadIdx.x == 0) {
        unsigned* bar = b.bar;
        __builtin_amdgcn_s_waitcnt(0);
        unsigned nloc = b.st[0], nx = b.st[1];
        if (nloc == 0u) { xcd_barrier_complete(bar, b.x, nloc, nx); b.st[0] = nloc; b.st[1] = nx; }
        const unsigned old = xb_add(&bar[XB_XSUB(b.x)], 1u);
        const unsigned gen = old / nloc;
        if (old + 1u == (gen + 1u) * nloc) {
            __builtin_amdgcn_fence(__ATOMIC_RELEASE, "agent");
            asm volatile("s_waitcnt vmcnt(0)" ::: "memory");
            const unsigned og = xb_add(&bar[XB_TOP], 1u);
            const unsigned tg = og / nx;
            if (og + 1u == (tg + 1u) * nx) xb_add(&bar[XB_TOPGEN], 1u);
            else XB_SPIN(xb_ld(&bar[XB_TOPGEN]) == tg, bar);
            __builtin_amdgcn_fence(__ATOMIC_ACQUIRE, "agent");
            xb_add(&bar[XB_XGEN(b.x)], 1u);
            asm volatile("s_waitcnt vmcnt(0)" ::: "memory");
        } else {
            XB_SPIN(xb_ld(&bar[XB_XGEN(b.x)]) == gen, bar);
            __builtin_amdgcn_fence(__ATOMIC_ACQUIRE, "agent");
            asm volatile("s_waitcnt vmcnt(0)" ::: "memory");
        }
    }
    __syncthreads();
}

__device__ __forceinline__ void group_arrive(unsigned* ctr) {
    asm volatile("s_waitcnt vmcnt(0)" ::: "memory");
    __syncthreads();
    if (threadIdx.x == 0) {
        __builtin_amdgcn_s_waitcnt(0);
        __builtin_amdgcn_fence(__ATOMIC_RELEASE, "agent");
        asm volatile("s_waitcnt vmcnt(0)" ::: "memory");
        (void)xb_add(ctr, 1u);
    }
}
__device__ __forceinline__ void group_wait(unsigned* bar, unsigned* ctr, unsigned expect) {
    if (threadIdx.x == 0) {
        XB_SPIN(xb_ld(ctr) < expect, bar);
        __builtin_amdgcn_fence(__ATOMIC_ACQUIRE, "agent");
        asm volatile("s_waitcnt vmcnt(0)" ::: "memory");
    }
    __syncthreads();
}

struct Frame {
    LAS unsigned char* lds;
    volatile LAS unsigned* MISC;
    gu32* ctl;
    int tid, lane, wave;
    int vcu, G;
    const float* x; float* out;
    const float *g_attn, *w_in, *g_sb, *g_ret, *w_out, *g_mlp, *w_up, *w_down, *g_fin;
    bf16 *XN, *WIN, *WOUT, *PROJ, *MIX, *WUP, *HID, *WDOWN, *ATT, *MLP;
    float *SBO, *ROPE, *UT, *PART1, *PARTSB, *RSTDX; bf16* ST;
};

__device__ __forceinline__ float wave_sum(float v) {
#pragma unroll
    for (int o = 1; o < 64; o <<= 1) v += __shfl_xor(v, o);
    return v;
}
__device__ __forceinline__ void p0_transpose_item(const float* W, int K, int N, bf16* WT, LAS float* scr, int item, int lane, const float* gk) {
    const int nblk = N / 32, kb = item / nblk, nb = item % nblk, k0 = 64 * kb, n0 = 32 * nb;
    float tv[32];
#pragma unroll
    for (int i = 0; i < 32; ++i) tv[i] = W[(size_t)(k0 + 2 * i + (lane >> 5)) * N + n0 + (lane & 31)];
    if (gk) {
#pragma unroll
        for (int i = 0; i < 32; ++i) tv[i] *= gk[k0 + 2 * i + (lane >> 5)];
    }
#pragma unroll
    for (int i = 0; i < 32; ++i) scr[(2 * i + (lane >> 5)) * 33 + (lane & 31)] = tv[i];
    LDS_WAIT(); asm volatile("" ::: "memory");
    const int c = lane & 7;
#pragma unroll
    for (int j = 0; j < 4; ++j) { const int n = (lane >> 3) + 8 * j; const LAS float* s = scr + (8 * c) * 33 + n;
        v4u o; o.x = pk2(s[0 * 33], s[1 * 33]); o.y = pk2(s[2 * 33], s[3 * 33]); o.z = pk2(s[4 * 33], s[5 * 33]); o.w = pk2(s[6 * 33], s[7 * 33]);
        *(GAS v4u*)(WT + (size_t)(n0 + n) * K + k0 + 8 * c) = o; }
    LDS_WAIT(); asm volatile("" ::: "memory");
}
__device__ __forceinline__ void tr_load(float (&tv)[32], const float* W, int N, int item, int lane) {
    const int nblk = N / 32, kb = item / nblk, nb = item % nblk, k0 = 64 * kb, n0 = 32 * nb;
#pragma unroll
    for (int i = 0; i < 32; ++i) tv[i] = __builtin_nontemporal_load(&W[(size_t)(k0 + 2 * i + (lane >> 5)) * N + n0 + (lane & 31)]);
}
__device__ __forceinline__ void tr_flush(float (&tv)[32], int K, int N, bf16* WT, LAS float* scr, int item, int lane, const float* gk) {
    const int nblk = N / 32, kb = item / nblk, nb = item % nblk, k0 = 64 * kb, n0 = 32 * nb;
    if (gk) {
#pragma unroll
        for (int i = 0; i < 32; ++i) tv[i] *= gk[k0 + 2 * i + (lane >> 5)];
    }
#pragma unroll
    for (int i = 0; i < 32; ++i) scr[(2 * i + (lane >> 5)) * 33 + (lane & 31)] = tv[i];
    LDS_WAIT(); asm volatile("" ::: "memory");
    const int c = lane & 7;
#pragma unroll
    for (int j = 0; j < 4; ++j) { const int n = (lane >> 3) + 8 * j; const LAS float* s = scr + (8 * c) * 33 + n;
        v4u o; o.x = pk2(s[0 * 33], s[1 * 33]); o.y = pk2(s[2 * 33], s[3 * 33]); o.z = pk2(s[4 * 33], s[5 * 33]); o.w = pk2(s[6 * 33], s[7 * 33]);
        *(GAS v4u*)(WT + (size_t)(n0 + n) * K + k0 + 8 * c) = o; }
    LDS_WAIT(); asm volatile("" ::: "memory");
}
__device__ __forceinline__ void transpose_items(const float* W, int K, int N, bf16* WT, LAS float* scr, int start, int step, int count, int lane, const float* gk, int gk_rows) {
    if (count <= 0) return;
    float ta[32], tb[32];
    const int nblk = N / 32;
    tr_load(ta, W, N, start, lane);
    for (int j = 0; j < count; j += 2) {
        const int i0 = start + j * step, i1 = i0 + step, i2 = i1 + step;
        if (j + 1 < count) tr_load(tb, W, N, i1, lane);
        tr_flush(ta, K, N, WT, scr, i0, lane, (64 * (i0 / nblk) < gk_rows) ? gk : nullptr);
        if (j + 2 < count) tr_load(ta, W, N, i2, lane);
        if (j + 1 < count) tr_flush(tb, K, N, WT, scr, i1, lane, (64 * (i1 / nblk) < gk_rows) ? gk : nullptr);
    }
}
__device__ __forceinline__ void transpose_matrix(Frame& F, const float* W, int K, int N, bf16* WT, const float* gk = nullptr, int gk_rows = 0) {
    LAS float* scr = (LAS float*)(F.lds + RING_OFF + F.wave * 16384);
    const int gw = F.vcu * NWAVES + F.wave, NGW = F.G * NWAVES;
    const int nitems = (K / 64) * (N / 32);
    transpose_items(W, K, N, WT, scr, gw, NGW, (nitems - gw + NGW - 1) / NGW, F.lane, gk, gk_rows);
}
__device__ __forceinline__ void drain_transposes(Frame& F, unsigned* ctr, const float* W, int K, int N, bf16* WT, const float* gk, int gk_rows = 1 << 30) {
    LAS float* scr = (LAS float*)(F.lds + RING_OFF + F.wave * 16384);
    const int nitems = (K / 64) * (N / 32);
    for (;;) {
        unsigned base = 0u;
        if (F.lane == 0) base = __hip_atomic_fetch_add(ctr, 8u, __ATOMIC_RELAXED, __HIP_MEMORY_SCOPE_AGENT);
        base = (unsigned)__builtin_amdgcn_readfirstlane((int)base);
        if (base >= (unsigned)nitems) break;
        { const int cnt = (nitems - (int)base) < 8 ? (nitems - (int)base) : 8; transpose_items(W, K, N, WT, scr, (int)base, 1, cnt, F.lane, gk, gk_rows); }
    }
}
template <int NJ, bool OUT_BF16>
__device__ __forceinline__ void rms_row(const float* xrow, const bf16* a1row, const bf16* a2row, const float* g, void* orow, int lane) {
    const GAS f32x4* xr = (const GAS f32x4*)xrow + lane;
    f32x4 v[NJ]; float s = 0.f;
#pragma unroll
    for (int j = 0; j < NJ; ++j) v[j] = xr[64 * j];
    if (a1row) {
        const GAS v2u* ar = (const GAS v2u*)a1row + lane;
#pragma unroll
        for (int j = 0; j < NJ; ++j) { const v2u w = ar[64 * j]; v[j] += (f32x4){bf_lo(w.x), bf_hi(w.x), bf_lo(w.y), bf_hi(w.y)}; }
    }
    if (a2row) {
        const GAS v2u* ar = (const GAS v2u*)a2row + lane;
#pragma unroll
        for (int j = 0; j < NJ; ++j) { const v2u w = ar[64 * j]; v[j] += (f32x4){bf_lo(w.x), bf_hi(w.x), bf_lo(w.y), bf_hi(w.y)}; }
    }
#pragma unroll
    for (int j = 0; j < NJ; ++j) s += (v[j].x * v[j].x + v[j].y * v[j].y) + (v[j].z * v[j].z + v[j].w * v[j].w);
    const float rstd = 1.0f / sqrtf(wave_sum(s) * (1.f / (256.f * NJ)) + EPS);
    const GAS f32x4* gr = (const GAS f32x4*)g + lane;
#pragma unroll
    for (int j = 0; j < NJ; ++j) { const f32x4 gg = gr[64 * j]; const f32x4 y = v[j] * rstd * gg;
        if constexpr (OUT_BF16) { v2u o; o.x = pk2(y.x, y.y); o.y = pk2(y.z, y.w); ((GAS v2u*)orow)[lane + 64 * j] = o; }
        else ((GAS f32x4*)orow)[lane + 64 * j] = y; }
}

__device__ __forceinline__ void cvt_row_rstd(const float* xrow, bf16* orow, float* rstd_out, int lane) {
    const GAS f32x4* xr = (const GAS f32x4*)xrow + lane;
    f32x4 v[16]; float s = 0.f;
#pragma unroll
    for (int j = 0; j < 16; ++j) v[j] = xr[64 * j];
#pragma unroll
    for (int j = 0; j < 16; ++j) { s += (v[j].x * v[j].x + v[j].y * v[j].y) + (v[j].z * v[j].z + v[j].w * v[j].w);
        v2u o; o.x = pk2(v[j].x, v[j].y); o.y = pk2(v[j].z, v[j].w); ((GAS v2u*)orow)[lane + 64 * j] = o; }
    const float rstd = 1.0f / sqrtf(wave_sum(s) * (1.f / 4096.f) + EPS);
    if (lane == 0) *rstd_out = rstd;
}

__device__ __forceinline__ void rms_row_bb(const bf16* a1row, const bf16* a2row, const float* g, float* orow, int lane) {
    const GAS v2u* ar = (const GAS v2u*)a1row + lane; const GAS v2u* br = (const GAS v2u*)a2row + lane;
    f32x4 v[16]; float s = 0.f;
#pragma unroll
    for (int j = 0; j < 16; ++j) { const v2u w = ar[64 * j]; v[j] = (f32x4){bf_lo(w.x), bf_hi(w.x), bf_lo(w.y), bf_hi(w.y)}; }
#pragma unroll
    for (int j = 0; j < 16; ++j) { const v2u w = br[64 * j]; v[j] += (f32x4){bf_lo(w.x), bf_hi(w.x), bf_lo(w.y), bf_hi(w.y)}; }
#pragma unroll
    for (int j = 0; j < 16; ++j) s += (v[j].x * v[j].x + v[j].y * v[j].y) + (v[j].z * v[j].z + v[j].w * v[j].w);
    const float rstd = 1.0f / sqrtf(wave_sum(s) * (1.f / 4096.f) + EPS);
    const GAS f32x4* gr = (const GAS f32x4*)g + lane;
#pragma unroll
    for (int j = 0; j < 16; ++j) ((GAS f32x4*)orow)[lane + 64 * j] = v[j] * rstd * gr[64 * j];
}

__constant__ float c_log2g[8] = { -0.04580368961312479f, -0.02272007650008353f, -0.011315313227834146f, -0.005646563141142063f,
                                  -0.0028205190623786626f, -0.0014095702546713536f, -0.0007046129765893727f, -0.0003522634716290214f };
struct EpiProj {
    static constexpr bool PERM = true, AFTER_DRAIN = false;
    bf16* O; const float* rope; const LAS float* tab;
    __device__ __forceinline__ void operator()(const pg8::f32x4 (&acc)[2][2][4][2], const pg8::Unit& u, int wr, int wc, int fr, int fq) const {
        const int kind = u.pn >> 3;
        const int row0 = u.pm * 256 + wr * 64 + fr, col0 = u.pn * 256 + wc * 32 + 8 * fq;
        if (kind == 3 || kind == 4) {
            const float L = c_log2g[u.pn & 7] * (kind == 3 ? 1.f : -1.f), mul = (kind == 3) ? 1.f : 0.0625f;
            const int i0 = wc * 32 + 8 * fq;
#pragma unroll
            for (int ai = 0; ai < 2; ++ai)
#pragma unroll
                for (int m = 0; m < 4; ++m) {
                    const int row = row0 + ai * 128 + m * 16, pos = row & (T - 1), tl = row & 255;
                    const float sc = __builtin_amdgcn_exp2f((float)(tl + 1) * L) * mul * tab[ai * 128 + wr * 64 + m * 16 + fr];
                    const float* cp = rope + (size_t)pos * 128 + i0; const float* sp = cp + (size_t)T * 128;
                    const f32x4 c0 = *(const f32x4*)cp, c1 = *(const f32x4*)(cp + 4), s0 = *(const f32x4*)sp, s1 = *(const f32x4*)(sp + 4);
                    const f32x4 a0 = acc[ai][0][m][0], a1 = acc[ai][0][m][1], b0 = acc[ai][1][m][0], b1 = acc[ai][1][m][1];
                    const f32x4 y0 = (a0 * c0 - b0 * s0) * sc, y1 = (a1 * c1 - b1 * s1) * sc, z0 = (b0 * c0 + a0 * s0) * sc, z1 = (b1 * c1 + a1 * s1) * sc;
                    bf16* rowp = O + (size_t)row * NIN + col0;
                    v4u w; w.x = pg8::cvt_pk_bf16(y0[0], y0[1]); w.y = pg8::cvt_pk_bf16(y0[2], y0[3]); w.z = pg8::cvt_pk_bf16(y1[0], y1[1]); w.w = pg8::cvt_pk_bf16(y1[2], y1[3]);
                    *(v4u*)rowp = w;
                    v4u w2; w2.x = pg8::cvt_pk_bf16(z0[0], z0[1]); w2.y = pg8::cvt_pk_bf16(z0[2], z0[3]); w2.z = pg8::cvt_pk_bf16(z1[0], z1[1]); w2.w = pg8::cvt_pk_bf16(z1[2], z1[3]);
                    *(v4u*)(rowp + 128) = w2;
                }
        } else {
            const float sc0 = (kind == 0) ? QSCALE : 1.f;
#pragma unroll
            for (int ai = 0; ai < 2; ++ai)
#pragma unroll
                for (int m = 0; m < 4; ++m) { bf16* rowp = O + (size_t)(row0 + ai * 128 + m * 16) * NIN + col0; const float sc = sc0 * tab[ai * 128 + wr * 64 + m * 16 + fr];
#pragma unroll
                    for (int bj = 0; bj < 2; ++bj) { f32x4 v0 = acc[ai][bj][m][0] * sc, v1 = acc[ai][bj][m][1] * sc;
                        if (kind == 6) {
#pragma unroll
                            for (int j = 0; j < 4; ++j) { v0[j] = v0[j] * __builtin_amdgcn_rcpf(1.f + __builtin_amdgcn_exp2f(-1.4426950408889634f * v0[j]));
                                                          v1[j] = v1[j] * __builtin_amdgcn_rcpf(1.f + __builtin_amdgcn_exp2f(-1.4426950408889634f * v1[j])); } }
                        v4u w; w.x = pg8::cvt_pk_bf16(v0[0], v0[1]); w.y = pg8::cvt_pk_bf16(v0[2], v0[3]); w.z = pg8::cvt_pk_bf16(v1[0], v1[1]); w.w = pg8::cvt_pk_bf16(v1[2], v1[3]);
                        *(v4u*)(rowp + bj * 128) = w; } }
        }
    }
};
struct EpiBf16 {
    static constexpr bool PERM = true, AFTER_DRAIN = false;
    bf16* O; int ldc;
    __device__ __forceinline__ void operator()(const pg8::f32x4 (&acc)[2][2][4][2], const pg8::Unit& u, int wr, int wc, int fr, int fq) const {
        const int row0 = u.pm * 256 + wr * 64 + fr, col0 = u.pn * 256 + wc * 32 + 8 * fq;
#pragma unroll
        for (int ai = 0; ai < 2; ++ai)
#pragma unroll
            for (int m = 0; m < 4; ++m) { bf16* rowp = O + (size_t)(row0 + ai * 128 + m * 16) * ldc + col0;
#pragma unroll
                for (int bj = 0; bj < 2; ++bj) { const f32x4 v0 = acc[ai][bj][m][0], v1 = acc[ai][bj][m][1];
                    v4u w; w.x = pg8::cvt_pk_bf16(v0[0], v0[1]); w.y = pg8::cvt_pk_bf16(v0[2], v0[3]); w.z = pg8::cvt_pk_bf16(v1[0], v1[1]); w.w = pg8::cvt_pk_bf16(v1[2], v1[3]);
                    *(v4u*)(rowp + bj * 128) = w; } }
    }
};
struct ScaleRowsAt {
    static constexpr bool ACTIVE = true;
    int T0; const LAS float* tab;
    __device__ __forceinline__ void operator()(int t, pg8::f32x4 (&acc)[2][2][4][2], int wr, int fr) const {
        if (t != T0) return;
#pragma unroll
        for (int ai = 0; ai < 2; ++ai)
#pragma unroll
            for (int m = 0; m < 4; ++m) { const float rs = tab[ai * 128 + wr * 64 + m * 16 + fr];
#pragma unroll
                for (int bj = 0; bj < 2; ++bj)
#pragma unroll
                    for (int n = 0; n < 2; ++n) acc[ai][bj][m][n] = acc[ai][bj][m][n] * rs; }
    }
};
struct EpiX1 {
    static constexpr bool PERM = true, AFTER_DRAIN = false;
    const bf16* x; bf16* O; float* part; int ldc;
    __device__ __forceinline__ void operator()(const pg8::f32x4 (&acc)[2][2][4][2], const pg8::Unit& u, int wr, int wc, int fr, int fq) const {
        const int row0 = u.pm * 256 + wr * 64 + fr, col0 = u.pn * 256 + wc * 32 + 8 * fq;
#pragma unroll
        for (int ai = 0; ai < 2; ++ai)
#pragma unroll
            for (int m = 0; m < 4; ++m) { const int row = row0 + ai * 128 + m * 16; const bf16* xr = x + (size_t)row * ldc + col0; bf16* rowp = O + (size_t)row * ldc + col0;
                float s = 0.f;
#pragma unroll
                for (int bj = 0; bj < 2; ++bj) { const v4u xw = *(const v4u*)(xr + bj * 128);
                    const f32x4 v0 = acc[ai][bj][m][0] + (f32x4){bf_lo(xw.x), bf_hi(xw.x), bf_lo(xw.y), bf_hi(xw.y)}, v1 = acc[ai][bj][m][1] + (f32x4){bf_lo(xw.z), bf_hi(xw.z), bf_lo(xw.w), bf_hi(xw.w)};
                    s += (v0[0] * v0[0] + v0[1] * v0[1]) + (v0[2] * v0[2] + v0[3] * v0[3]) + (v1[0] * v1[0] + v1[1] * v1[1]) + (v1[2] * v1[2] + v1[3] * v1[3]);
                    v4u w; w.x = pg8::cvt_pk_bf16(v0[0], v0[1]); w.y = pg8::cvt_pk_bf16(v0[2], v0[3]); w.z = pg8::cvt_pk_bf16(v1[0], v1[1]); w.w = pg8::cvt_pk_bf16(v1[2], v1[3]);
                    *(v4u*)(rowp + bj * 128) = w; }
                s += __shfl_xor(s, 16); s += __shfl_xor(s, 32);
                if (fq == 0) part[(size_t)row * 64 + u.pn * 4 + wc] = s; }
    }
};
struct EpiRelu2S {
    static constexpr bool PERM = true, AFTER_DRAIN = false;
    bf16* O; int ldc; const LAS float* tab;
    __device__ __forceinline__ void operator()(const pg8::f32x4 (&acc)[2][2][4][2], const pg8::Unit& u, int wr, int wc, int fr, int fq) const {
        const int row0 = u.pm * 256 + wr * 64 + fr, col0 = u.pn * 256 + wc * 32 + 8 * fq;
#pragma unroll
        for (int ai = 0; ai < 2; ++ai)
#pragma unroll
            for (int m = 0; m < 4; ++m) { bf16* rowp = O + (size_t)(row0 + ai * 128 + m * 16) * ldc + col0; const float rs = tab[ai * 128 + wr * 64 + m * 16 + fr];
#pragma unroll
                for (int bj = 0; bj < 2; ++bj) { f32x4 v0 = acc[ai][bj][m][0], v1 = acc[ai][bj][m][1];
#pragma unroll
                    for (int j = 0; j < 4; ++j) { const float a = fmaxf(v0[j], 0.f) * rs, b = fmaxf(v1[j], 0.f) * rs; v0[j] = a * a; v1[j] = b * b; }
                    v4u w; w.x = pg8::cvt_pk_bf16(v0[0], v0[1]); w.y = pg8::cvt_pk_bf16(v0[2], v0[3]); w.z = pg8::cvt_pk_bf16(v1[0], v1[1]); w.w = pg8::cvt_pk_bf16(v1[2], v1[3]);
                    *(v4u*)(rowp + bj * 128) = w; } }
    }
};

__device__ __forceinline__ void p0_prologue(Frame& F) {
    transpose_matrix(F, F.w_in, D, NIN, F.WIN, F.g_attn, D);
    if (!DEFER_OUT) transpose_matrix(F, F.w_out, D, D, F.WOUT, F.g_sb, 2048);
    if (!DEFER_UP) transpose_matrix(F, F.w_up, D, FF, F.WUP, F.g_mlp, D);
    if (!DEFER_DOWN) transpose_matrix(F, F.w_down, FF, D, F.WDOWN);
    const int gw = F.vcu * NWAVES + F.wave, NGW = F.G * NWAVES;
    for (int m = gw; m < M; m += NGW) cvt_row_rstd(F.x + (size_t)m * D, F.XN + (size_t)m * D, F.RSTDX + m, F.lane);
    for (int e = (F.vcu * NWAVES + F.wave) * 64 + F.lane; e < T * 128; e += NGW * 64) {
        const int pos = e >> 7, i = e & 127;
        const double inv = exp2(-(double)i * 0.10381025296523007);
        const double rev = (double)pos * inv * 0.15915494309189535;
        const float fr = (float)(rev - floor(rev));
        F.ROPE[e] = __builtin_amdgcn_cosf(fr); F.ROPE[(size_t)T * 128 + e] = __builtin_amdgcn_sinf(fr);
    }
}

namespace sba {
using bf16x8 = __attribute__((ext_vector_type(8))) short;
using s16x4  = __attribute__((ext_vector_type(4))) short;
using f32x16 = __attribute__((ext_vector_type(16))) float;
using u32x4  = __attribute__((ext_vector_type(4))) unsigned;
constexpr int DH = 128, KVBLK = 64, LDK = NIN;
constexpr int SHM_V = KVBLK * DH * 2, SHM_K = KVBLK * DH * 2;
#define SBA_KSWZ(row, colB) ((row) * 256 + ((colB) ^ (((row) & 7) << 4)))
#define SBA_SBAR() __builtin_amdgcn_sched_barrier(0)
__device__ __forceinline__ int crow(int r, int hi) { return (r & 3) + 8 * (r >> 2) + 4 * hi; }
__device__ __forceinline__ unsigned cvtpk(float lo, float hi) { unsigned r; asm volatile("v_cvt_pk_bf16_f32 %0, %1, %2" : "=v"(r) : "v"(lo), "v"(hi)); return r; }
__device__ __forceinline__ void qkt(f32x16& p0, f32x16& p1, const char* Ks, const char* Qs, int r32, int hi) {
  p0 = f32x16{}; p1 = f32x16{};
#pragma unroll
  for (int d0 = 0; d0 < 8; ++d0) { const int cb = (d0 * 16 + hi * 8) * 2;
    const bf16x8 b0 = *reinterpret_cast<const bf16x8*>(Ks + SBA_KSWZ(r32, cb));
    const bf16x8 b1 = *reinterpret_cast<const bf16x8*>(Ks + SBA_KSWZ(32 + r32, cb));
    const bf16x8 q = *reinterpret_cast<const bf16x8*>(Qs + d0 * 1024);
    p0 = __builtin_amdgcn_mfma_f32_32x32x16_bf16(b0, q, p0, 0, 0, 0);
    p1 = __builtin_amdgcn_mfma_f32_32x32x16_bf16(b1, q, p1, 0, 0, 0); }
}
__device__ __forceinline__ int v_st(int k, int c) { const int kk = (k & ~0xC) | ((k & 4) << 1) | ((k & 8) >> 1); return ((kk >> 3) * 4 + (c >> 5)) * 512 + ((kk & 7) * 32 + (c & 31)) * 2; }
__device__ __forceinline__ int v_rd_base(int lane) { return ((lane & 3) << 3) | (((lane >> 2) & 3) << 6) | (((lane >> 4) & 1) << 5) | (((lane >> 5) & 1) << 8); }
constexpr int v_rd_off(int d0, int ks, int half) { return d0 * 512 + ks * 4096 + half * 2048; }
template <int OFF> __device__ __forceinline__ s16x4 tr_read(int vb) {
  s16x4 r; asm volatile("ds_read_b64_tr_b16 %0, %1 offset:%2" : "=&v"(r) : "v"(vb), "i"(OFF) : "memory"); return r;
}
template <int D0> __device__ __forceinline__ void pv_one(f32x16& od, int vb, bf16x8 pa0, bf16x8 pa1, bf16x8 pa2, bf16x8 pa3) {
  const s16x4 l0 = tr_read<v_rd_off(D0, 0, 0)>(vb), h0 = tr_read<v_rd_off(D0, 0, 1)>(vb), l1 = tr_read<v_rd_off(D0, 1, 0)>(vb), h1 = tr_read<v_rd_off(D0, 1, 1)>(vb);
  const s16x4 l2 = tr_read<v_rd_off(D0, 2, 0)>(vb), h2 = tr_read<v_rd_off(D0, 2, 1)>(vb), l3 = tr_read<v_rd_off(D0, 3, 0)>(vb), h3 = tr_read<v_rd_off(D0, 3, 1)>(vb);
  asm volatile("s_waitcnt lgkmcnt(0)" ::: "memory"); SBA_SBAR();
#define SBA_PK(L, H) (bf16x8){L[0], L[1], L[2], L[3], H[0], H[1], H[2], H[3]}
  od = __builtin_amdgcn_mfma_f32_32x32x16_bf16(pa0, SBA_PK(l0, h0), od, 0, 0, 0);
  od = __builtin_amdgcn_mfma_f32_32x32x16_bf16(pa1, SBA_PK(l1, h1), od, 0, 0, 0);
  od = __builtin_amdgcn_mfma_f32_32x32x16_bf16(pa2, SBA_PK(l2, h2), od, 0, 0, 0);
  od = __builtin_amdgcn_mfma_f32_32x32x16_bf16(pa3, SBA_PK(l3, h3), od, 0, 0, 0);
#undef SBA_PK
}
template <bool MASKED>
__device__ __forceinline__ void sb_weights(f32x16& p0, f32x16& p1, float& R, int hi, int lim) {
#pragma unroll
  for (int r = 0; r < 16; ++r) {
    const float e0 = __builtin_amdgcn_exp2f(-p0[r]), e1 = __builtin_amdgcn_exp2f(-p1[r]);
    float b0 = __builtin_amdgcn_rcpf(1.f + e0), b1 = __builtin_amdgcn_rcpf(1.f + e1);
    if (MASKED) { b0 = (crow(r, hi) < lim) ? b0 : 0.f; b1 = (32 + crow(r, hi) < lim) ? b1 : 0.f; }
    p0[r] = b0; p1[r] = b1;
  }
  float run = R;
#pragma unroll
  for (int G = 7; G >= 0; --G) {
    float gp;
    if (G < 4) gp = ((1.f - p0[4 * G]) * (1.f - p0[4 * G + 1])) * ((1.f - p0[4 * G + 2]) * (1.f - p0[4 * G + 3]));
    else       gp = ((1.f - p1[4 * G - 16]) * (1.f - p1[4 * G - 15])) * ((1.f - p1[4 * G - 14]) * (1.f - p1[4 * G - 13]));
    const auto rr = __builtin_amdgcn_permlane32_swap(__float_as_uint(gp), __float_as_uint(gp), false, false);
    const float glo = __uint_as_float(rr[0]), ghi = __uint_as_float(rr[1]);
    float t = run * (hi ? 1.f : ghi);
    if (G < 4) {
      const float a3 = p0[4 * G + 3] * t; t -= a3; const float a2 = p0[4 * G + 2] * t; t -= a2; const float a1 = p0[4 * G + 1] * t; t -= a1; const float a0 = p0[4 * G] * t;
      p0[4 * G] = a0; p0[4 * G + 1] = a1; p0[4 * G + 2] = a2; p0[4 * G + 3] = a3;
    } else {
      const int g = G - 4;
      const float a3 = p1[4 * g + 3] * t; t -= a3; const float a2 = p1[4 * g + 2] * t; t -= a2; const float a1 = p1[4 * g + 1] * t; t -= a1; const float a0 = p1[4 * g] * t;
      p1[4 * g] = a0; p1[4 * g + 1] = a1; p1[4 * g + 2] = a2; p1[4 * g + 3] = a3;
    }
    run *= glo * ghi;
  }
  R = run;
}
__device__ __forceinline__ void pack_p(const f32x16& p0, const f32x16& p1, bf16x8& pa0, bf16x8& pa1, bf16x8& pa2, bf16x8& pa3) {
#define SBA_PK4(P, BASE, OUT) do { unsigned a0 = cvtpk(P[BASE + 0], P[BASE + 1]), a1 = cvtpk(P[BASE + 2], P[BASE + 3]);   \
    unsigned b0 = cvtpk(P[BASE + 4], P[BASE + 5]), b1 = cvtpk(P[BASE + 6], P[BASE + 7]);                              \
    auto r0 = __builtin_amdgcn_permlane32_swap(a0, b0, false, false); auto r1 = __builtin_amdgcn_permlane32_swap(a1, b1, false, false); \
    u32x4 w = {r0[0], r1[0], r0[1], r1[1]}; OUT = *reinterpret_cast<bf16x8*>(&w); } while (0)
  SBA_PK4(p0, 0, pa0); SBA_PK4(p0, 8, pa1); SBA_PK4(p1, 0, pa2); SBA_PK4(p1, 8, pa3);
#undef SBA_PK4
}
__device__ __forceinline__ void unit(const bf16* __restrict__ Qh, const bf16* __restrict__ Kh, const bf16* __restrict__ Vh, bf16* __restrict__ Oh, float* __restrict__ Ph, int q0, char* lds) {
  int tid = threadIdx.x; asm volatile("" : "+v"(tid));
  const int wid = tid >> 6, lane = tid & 63, r32 = lane & 31, hi = lane >> 5;
  char* V_lds = lds; char* K_lds = lds + 2 * SHM_V;
  volatile int* flags = (volatile int*)(lds + LDSCTL_OFF);
  char* Qs = lds + 2 * SHM_V + 2 * SHM_K + wid * 8192 + lane * 16;
  f32x16 o[4] = {};
  const int qrow0 = q0 + wid * 32;
  bf16x8 qv[8];
  { const bf16* Qw = Qh + (size_t)(qrow0 + r32) * LDK + hi * 8;
#pragma unroll
    for (int d0 = 0; d0 < 8; ++d0) qv[d0] = *reinterpret_cast<const bf16x8*>(Qw + d0 * 16); }
  const int sr = tid >> 4, sc = (tid & 15) * 8, vst0 = v_st(sr, sc), vst1 = v_st(32 + sr, sc);
  const int vb0 = (int)(uintptr_t)V_lds + v_rd_base(lane);
  bf16x8 vsA0, vsA1, ksA0, ksA1, vsB0, vsB1, ksB0, ksB1;
#define SBA_SLOAD(S, k0) do { vs##S##0 = *reinterpret_cast<const bf16x8*>(&Vh[(size_t)((k0) + sr) * LDK + sc]); vs##S##1 = *reinterpret_cast<const bf16x8*>(&Vh[(size_t)((k0) + 32 + sr) * LDK + sc]); \
    ks##S##0 = *reinterpret_cast<const bf16x8*>(&Kh[(size_t)((k0) + sr) * LDK + sc]); ks##S##1 = *reinterpret_cast<const bf16x8*>(&Kh[(size_t)((k0) + 32 + sr) * LDK + sc]); } while (0)
#define SBA_SWRITE(S, b) do { *(bf16x8*)(V_lds + (b) * SHM_V + vst0) = vs##S##0; *(bf16x8*)(V_lds + (b) * SHM_V + vst1) = vs##S##1; const int kc = sc * 2; \
    *(bf16x8*)(K_lds + (b) * SHM_K + SBA_KSWZ(sr, kc)) = ks##S##0; *(bf16x8*)(K_lds + (b) * SHM_K + SBA_KSWZ(32 + sr, kc)) = ks##S##1; } while (0)
#define SBA_TILE(j, buf) do { const int k0 = (NT - 1 - (j)) * KVBLK; const int lim = qrow0 + r32 - k0; const bool live = __any(R != 0.f); \
    if (k0 < qrow0 + 32 && live) { f32x16 p0, p1; bf16x8 pa0, pa1, pa2, pa3; \
      qkt(p0, p1, K_lds + (buf) * SHM_K, Qs, r32, hi); \
      if (k0 + KVBLK <= qrow0) sb_weights<false>(p0, p1, R, hi, lim); else sb_weights<true>(p0, p1, R, hi, lim); \
      pack_p(p0, p1, pa0, pa1, pa2, pa3); const int vb = vb0 + (buf) * SHM_V; \
      pv_one<0>(o[0], vb, pa0, pa1, pa2, pa3); pv_one<1>(o[1], vb, pa0, pa1, pa2, pa3); pv_one<2>(o[2], vb, pa0, pa1, pa2, pa3); pv_one<3>(o[3], vb, pa0, pa1, pa2, pa3); } \
    { const int al = __any(R != 0.f) ? 1 : 0; if (lane == 0) flags[wid] = al; } } while (0)
#define SBA_ALIVE(j) ({ int alive_ = 0; _Pragma("unroll") for (int w_ = 0; w_ < 8; ++w_) alive_ |= flags[w_]; flags = (volatile int*)(lds + LDSCTL_OFF + (((j) + 1) & 1) * 32); alive_; })
  const int NT = (q0 + 256) / KVBLK;
  float R = 1.f;
  SBA_SLOAD(A, (NT - 1) * KVBLK); SBA_SLOAD(B, (NT - 2) * KVBLK);
  __syncthreads();
#pragma unroll
  for (int d0 = 0; d0 < 8; ++d0) *reinterpret_cast<bf16x8*>(Qs + d0 * 1024) = qv[d0];
  SBA_SWRITE(A, 0); __syncthreads();
  for (int j = 0; j < NT; j += 2) {
    if (j + 2 < NT) SBA_SLOAD(A, (NT - 3 - j) * KVBLK);
    SBA_TILE(j, 0);
    SBA_SWRITE(B, 1);
    __syncthreads();
    if (!SBA_ALIVE(j)) break;
    if (j + 3 < NT) SBA_SLOAD(B, (NT - 4 - j) * KVBLK);
    SBA_TILE(j + 1, 1);
    if (j + 2 < NT) SBA_SWRITE(A, 0);
    __syncthreads();
    if (!SBA_ALIVE(j + 1)) break;
  }
#undef SBA_TILE
#undef SBA_ALIVE
  { LAS unsigned char* slab = (LAS unsigned char*)lds + 2 * SHM_V + 2 * SHM_K + wid * 8192;
#pragma unroll
    for (int r = 0; r < 16; ++r) { const int orow = crow(r, hi);
      float s = (o[0][r] * o[0][r] + o[1][r] * o[1][r]) + (o[2][r] * o[2][r] + o[3][r] * o[3][r]);
#pragma unroll
      for (int d0 = 0; d0 < 4; ++d0) *(LAS unsigned short*)(slab + orow * 256 + (d0 * 32 + r32) * 2) = (unsigned short)f2bf(o[d0][r]);
      s += __shfl_xor(s, 1); s += __shfl_xor(s, 2); s += __shfl_xor(s, 4); s += __shfl_xor(s, 8); s += __shfl_xor(s, 16);
      if (r32 == 0) Ph[(size_t)(qrow0 + orow) * 16] = s; }
    asm volatile("s_waitcnt lgkmcnt(0)" ::: "memory");
    bf16* Ow = Oh + (size_t)qrow0 * D;
#pragma unroll
    for (int i = 0; i < 8; ++i) { const int row = 4 * i + (lane >> 4), ch = lane & 15;
      const u32x4 v = *(const LAS u32x4*)(slab + row * 256 + ch * 16);
      *(u32x4*)(Ow + (size_t)row * D + ch * 8) = v; }
  }
#undef SBA_SLOAD
#undef SBA_SWRITE
}
}

__device__ __forceinline__ void sb_fast_phase(Frame& F) {
  for (int p = blockIdx.x; p < 512; p += F.G) {
    const int bh = p >> 4, x = p & 15, b = bh >> 4, h = bh & 15;
    const bf16* base = F.PROJ + (size_t)b * T * NIN + h * SBD;
    bf16* Oh = F.MIX + (size_t)b * T * D + h * SBD; float* Ph = F.PARTSB + (size_t)b * T * 16 + h;
    sba::unit(base + C_SBQ, base + C_SBK, base + C_SBV, Oh, Ph, (31 - x) * 256, (char*)F.lds);
    sba::unit(base + C_SBQ, base + C_SBK, base + C_SBV, Oh, Ph, x * 256, (char*)F.lds);
  }
  __syncthreads();
}


namespace ret {
using sba::bf16x8; using sba::s16x4; using sba::f32x16; using sba::u32x4; using sba::crow; using sba::v_st; using sba::v_rd_base; using sba::v_rd_off; using sba::tr_read;
constexpr int IMG = 16384;
template <int D0, int KS> __device__ __forceinline__ bf16x8 tr_frag(int vb) {
  const s16x4 l = tr_read<v_rd_off(D0, KS, 0)>(vb), h = tr_read<v_rd_off(D0, KS, 1)>(vb);
  return (bf16x8){l[0], l[1], l[2], l[3], h[0], h[1], h[2], h[3]};
}
__device__ __forceinline__ void tile_load(bf16x8 (&v)[4], const bf16* __restrict__ src, size_t pitch, int tid) {
  const int sr = tid >> 4, sc = (tid & 15) * 8;
#pragma unroll
  for (int i = 0; i < 4; ++i) v[i] = *reinterpret_cast<const bf16x8*>(src + (size_t)(sr + 32 * (i & 1)) * pitch + (i >> 1) * 128 + sc);
}
template <bool VST> __device__ __forceinline__ void tile_write(const bf16x8 (&v)[4], char* dst, int tid) {
  const int sr = tid >> 4, sc = (tid & 15) * 8;
#pragma unroll
  for (int i = 0; i < 4; ++i) { const int row = sr + 32 * (i & 1); const int off = VST ? v_st(row, sc) : SBA_KSWZ(row, sc * 2);
    *reinterpret_cast<bf16x8*>(dst + (i >> 1) * IMG + off) = v[i]; }
}
template <int KS> __device__ __forceinline__ void passA_step(f32x16 (&acc)[2][4], int vbV, int vbK) {
  const bf16x8 a0 = tr_frag<0, KS>(vbV), a1 = tr_frag<1, KS>(vbV);
  const bf16x8 b0 = tr_frag<0, KS>(vbK), b1 = tr_frag<1, KS>(vbK), b2 = tr_frag<2, KS>(vbK), b3 = tr_frag<3, KS>(vbK);
  asm volatile("s_waitcnt lgkmcnt(0)" ::: "memory"); SBA_SBAR();
  acc[0][0] = __builtin_amdgcn_mfma_f32_32x32x16_bf16(a0, b0, acc[0][0], 0, 0, 0); acc[0][1] = __builtin_amdgcn_mfma_f32_32x32x16_bf16(a0, b1, acc[0][1], 0, 0, 0);
  acc[0][2] = __builtin_amdgcn_mfma_f32_32x32x16_bf16(a0, b2, acc[0][2], 0, 0, 0); acc[0][3] = __builtin_amdgcn_mfma_f32_32x32x16_bf16(a0, b3, acc[0][3], 0, 0, 0);
  acc[1][0] = __builtin_amdgcn_mfma_f32_32x32x16_bf16(a1, b0, acc[1][0], 0, 0, 0); acc[1][1] = __builtin_amdgcn_mfma_f32_32x32x16_bf16(a1, b1, acc[1][1], 0, 0, 0);
  acc[1][2] = __builtin_amdgcn_mfma_f32_32x32x16_bf16(a1, b2, acc[1][2], 0, 0, 0); acc[1][3] = __builtin_amdgcn_mfma_f32_32x32x16_bf16(a1, b3, acc[1][3], 0, 0, 0);
}
__device__ __forceinline__ void unitA(const bf16* __restrict__ Kc, const bf16* __restrict__ Vc, float* __restrict__ UT, char* lds) {
  int tid = threadIdx.x; asm volatile("" : "+v"(tid));
  const int wid = tid >> 6, lane = tid & 63, r32 = lane & 31, hi = lane >> 5, wr = wid >> 1, wc = wid & 1;
  f32x16 acc[2][4] = {};
  const int vbase = (int)(uintptr_t)lds + v_rd_base(lane);
  const int vbK = vbase + wc * IMG;
  const int vbV = vbase + 4 * IMG + (wr >> 1) * IMG + (wr & 1) * 1024;
  bf16x8 k0r[4], v0r[4], k1r[4], v1r[4];
  tile_load(k0r, Kc, NIN, tid); tile_load(v0r, Vc, NIN, tid); tile_load(k1r, Kc + (size_t)64 * NIN, NIN, tid); tile_load(v1r, Vc + (size_t)64 * NIN, NIN, tid);
  __syncthreads();
  tile_write<true>(k0r, lds, tid); tile_write<true>(v0r, lds + 4 * IMG, tid); tile_write<true>(k1r, lds + 2 * IMG, tid); tile_write<true>(v1r, lds + 6 * IMG, tid);
  __syncthreads();
  tile_load(k0r, Kc + (size_t)128 * NIN, NIN, tid); tile_load(v0r, Vc + (size_t)128 * NIN, NIN, tid); tile_load(k1r, Kc + (size_t)192 * NIN, NIN, tid); tile_load(v1r, Vc + (size_t)192 * NIN, NIN, tid);
  passA_step<0>(acc, vbV, vbK); passA_step<1>(acc, vbV, vbK); passA_step<2>(acc, vbV, vbK); passA_step<3>(acc, vbV, vbK);
  passA_step<0>(acc, vbV + 2 * IMG, vbK + 2 * IMG); passA_step<1>(acc, vbV + 2 * IMG, vbK + 2 * IMG); passA_step<2>(acc, vbV + 2 * IMG, vbK + 2 * IMG); passA_step<3>(acc, vbV + 2 * IMG, vbK + 2 * IMG);
  __syncthreads();
  tile_write<true>(k0r, lds, tid); tile_write<true>(v0r, lds + 4 * IMG, tid); tile_write<true>(k1r, lds + 2 * IMG, tid); tile_write<true>(v1r, lds + 6 * IMG, tid);
  __syncthreads();
  passA_step<0>(acc, vbV, vbK); passA_step<1>(acc, vbV, vbK); passA_step<2>(acc, vbV, vbK); passA_step<3>(acc, vbV, vbK);
  passA_step<0>(acc, vbV + 2 * IMG, vbK + 2 * IMG); passA_step<1>(acc, vbV + 2 * IMG, vbK + 2 * IMG); passA_step<2>(acc, vbV + 2 * IMG, vbK + 2 * IMG); passA_step<3>(acc, vbV + 2 * IMG, vbK + 2 * IMG);
#pragma unroll
  for (int a = 0; a < 2; ++a)
#pragma unroll
    for (int bb = 0; bb < 4; ++bb)
#pragma unroll
      for (int r = 0; r < 16; ++r) UT[(size_t)(64 * wr + 32 * a + crow(r, hi)) * 256 + 128 * wc + 32 * bb + r32] = acc[a][bb][r];
}
constexpr int KP = 528, KPAD_BYTES = 64 * KP;
__device__ __forceinline__ void rows_load(bf16x8 (&v)[4], const bf16* __restrict__ src, size_t pitch, int tid) {
  const int sr = tid >> 5, sc = (tid & 31) * 8;
#pragma unroll
  for (int i = 0; i < 4; ++i) v[i] = *reinterpret_cast<const bf16x8*>(src + (size_t)(sr + 16 * i) * pitch + sc);
}
__device__ __forceinline__ void rows_write(const bf16x8 (&v)[4], char* dst, int tid) {
  const int sr = tid >> 5, sc = (tid & 31) * 8;
#pragma unroll
  for (int i = 0; i < 4; ++i) *reinterpret_cast<bf16x8*>(dst + (sr + 16 * i) * KP + sc * 2) = v[i];
}
__device__ __forceinline__ void qkt256(f32x16& p0, f32x16& p1, const char* Kl, const char* Qs) {
  p0 = f32x16{}; p1 = f32x16{};
#pragma unroll
  for (int ks = 0; ks < 16; ++ks) {
    const bf16x8 b0 = *reinterpret_cast<const bf16x8*>(Kl + ks * 32);
    const bf16x8 b1 = *reinterpret_cast<const bf16x8*>(Kl + 32 * KP + ks * 32);
    const bf16x8 q = *reinterpret_cast<const bf16x8*>(Qs + ks * 1024);
    p0 = __builtin_amdgcn_mfma_f32_32x32x16_bf16(b0, q, p0, 0, 0, 0);
    p1 = __builtin_amdgcn_mfma_f32_32x32x16_bf16(b1, q, p1, 0, 0, 0);
    if ((ks & 3) == 3) SBA_SBAR(); }
}
__device__ __forceinline__ void cross_mma(f32x16& oi, const char* Sl, const char* Qs) {
#pragma unroll
  for (int ks = 0; ks < 16; ++ks) {
    const bf16x8 bfr = *reinterpret_cast<const bf16x8*>(Sl + ks * 32);
    const bf16x8 q = *reinterpret_cast<const bf16x8*>(Qs + ks * 1024);
    oi = __builtin_amdgcn_mfma_f32_32x32x16_bf16(q, bfr, oi, 0, 0, 0);
    if ((ks & 3) == 3) SBA_SBAR(); }
}
constexpr int R1_OFF = 65536, R2_OFF = 65536 + KPAD_BYTES;
__device__ __forceinline__ void unitC(const bf16* __restrict__ Qc, const bf16* __restrict__ Kc, const bf16* __restrict__ Vc, const bf16* __restrict__ Gc, const bf16* __restrict__ ST, bool has_state,
                                      const float* __restrict__ gn, bf16* __restrict__ Mc, int r0, char* lds) {
  int tid = threadIdx.x; asm volatile("" : "+v"(tid));
  const int wid = tid >> 6, lane = tid & 63, r32 = lane & 31, hi = lane >> 5, rg = wid & 3, dh = wid >> 2;
  f32x16 o[4] = {};
  const int qrow0 = r0 + 32 * rg;
  char* Qs = lds + rg * 16384 + lane * 16;
  const char* Kl = lds + R1_OFF + r32 * KP + hi * 16;
  const char* Sl1 = lds + R1_OFF + (dh * 32 + r32) * KP + hi * 16;
  const char* Sl2 = lds + R2_OFF + (dh * 32 + r32) * KP + hi * 16;
  const int vb0 = (int)(uintptr_t)lds + R2_OFF + v_rd_base(lane) + dh * 512;
  const int ntile = (r0 + 128) / 64;
  bf16x8 sa[4], sb[4];
  unsigned offK[4], offS[4], offV[4];
#pragma unroll
  for (int i = 0; i < 4; ++i) { offK[i] = (unsigned)(((tid >> 5) + 16 * i) * NIN + (tid & 31) * 8) * 2u; offS[i] = (unsigned)(((tid >> 5) + 16 * i) * 256 + (tid & 31) * 8) * 2u;
    offV[i] = (unsigned)(((tid >> 4) + 32 * (i & 1)) * NIN + (i >> 1) * 128 + (tid & 15) * 8) * 2u; }
#define RC_LD(dst, base, off) do { _Pragma("unroll") for (int i_ = 0; i_ < 4; ++i_) dst[i_] = *reinterpret_cast<const bf16x8*>(reinterpret_cast<const char*>(base) + (off)[i_]); } while (0)
  if (has_state) { RC_LD(sa, ST, offS); RC_LD(sb, ST + (size_t)64 * 256, offS); }
  else { RC_LD(sa, Kc, offK); RC_LD(sb, Vc, offV); }
  bf16x8 qv[8];
  { const bf16* Qw = Qc + (size_t)(qrow0 + r32) * NIN + hi * 8 + dh * 128;
#pragma unroll
    for (int k8 = 0; k8 < 8; ++k8) qv[k8] = *reinterpret_cast<const bf16x8*>(Qw + k8 * 16); }
  __syncthreads();
#pragma unroll
  for (int k8 = 0; k8 < 8; ++k8) *reinterpret_cast<bf16x8*>(Qs + (dh * 8 + k8) * 1024) = qv[k8];
  rows_write(sa, lds + R1_OFF, tid);
  if (has_state) rows_write(sb, lds + R2_OFF, tid); else tile_write<true>(sb, lds + R2_OFF, tid);
  __syncthreads();
  if (has_state) {
    RC_LD(sa, ST + (size_t)128 * 256, offS); RC_LD(sb, ST + (size_t)192 * 256, offS);
    cross_mma(o[0], Sl1, Qs); cross_mma(o[1], Sl2, Qs);
    __syncthreads(); rows_write(sa, lds + R1_OFF, tid); rows_write(sb, lds + R2_OFF, tid); __syncthreads();
    RC_LD(sa, Kc, offK); RC_LD(sb, Vc, offV);
    cross_mma(o[2], Sl1, Qs); cross_mma(o[3], Sl2, Qs);
    __syncthreads(); rows_write(sa, lds + R1_OFF, tid); tile_write<true>(sb, lds + R2_OFF, tid); __syncthreads();
  }
  for (int kt = 0; kt < ntile; ++kt) {
    const int k0 = kt * 64;
    if (kt + 1 < ntile) { RC_LD(sa, Kc + (size_t)(k0 + 64) * NIN, offK); RC_LD(sb, Vc + (size_t)(k0 + 64) * NIN, offV); }
    if (k0 <= qrow0 + 31) {
      f32x16 p0, p1; bf16x8 pa0, pa1, pa2, pa3;
      qkt256(p0, p1, Kl, Qs);
      if (k0 + 63 > qrow0) {
        const int lim = qrow0 + r32 - k0 + 1;
#pragma unroll
        for (int r = 0; r < 16; ++r) { p0[r] = (crow(r, hi) < lim) ? p0[r] : 0.f; p1[r] = (32 + crow(r, hi) < lim) ? p1[r] : 0.f; }
      }
      sba::pack_p(p0, p1, pa0, pa1, pa2, pa3);
      sba::pv_one<0>(o[0], vb0, pa0, pa1, pa2, pa3); sba::pv_one<2>(o[1], vb0, pa0, pa1, pa2, pa3);
      sba::pv_one<0>(o[2], vb0 + IMG, pa0, pa1, pa2, pa3); sba::pv_one<2>(o[3], vb0 + IMG, pa0, pa1, pa2, pa3);
    }
    __syncthreads();
    if (kt + 1 < ntile) { rows_write(sa, lds + R1_OFF, tid); tile_write<true>(sb, lds + R2_OFF, tid); __syncthreads(); }
  }
  int le = lane; asm volatile("" : "+v"(le));
  v2u gwv[16];
#pragma unroll
  for (int rr = 0; rr < 16; ++rr) gwv[rr] = *(const v2u*)(Gc + (size_t)(r0 + wid * 16 + rr) * NIN + le * 4);
  const f32x4 gg = *(const f32x4*)(gn + le * 4);
  float* Ol = (float*)lds;
#pragma unroll
  for (int i = 0; i < 4; ++i)
#pragma unroll
    for (int r = 0; r < 16; ++r) Ol[(32 * rg + crow(r, hi)) * 256 + (2 * i + dh) * 32 + r32] = o[i][r];
  __syncthreads();
#pragma unroll
  for (int rr = 0; rr < 16; ++rr) {
    const int row = wid * 16 + rr;
    const f32x4 v = *(const f32x4*)(Ol + row * 256 + le * 4);
    const float mu = wave_sum((v.x + v.y) + (v.z + v.w)) * (1.f / 256.f);
    const f32x4 d = v - mu;
    const float var = wave_sum((d.x * d.x + d.y * d.y) + (d.z * d.z + d.w * d.w)) * (1.f / 256.f);
    const float rstd = 1.0f / sqrtf(var + EPS);
    const v2u gw = gwv[rr];
    const f32x4 y = d * rstd * gg * (f32x4){bf_lo(gw.x), bf_hi(gw.x), bf_lo(gw.y), bf_hi(gw.y)};
    v2u ow; ow.x = pk2(y.x, y.y); ow.y = pk2(y.z, y.w);
    *(v2u*)(Mc + (size_t)(r0 + row) * D + le * 4) = ow;
  }
#undef RC_LD
}
}

__device__ __forceinline__ void ret_passA_phase(Frame& F) {
  for (int u = blockIdx.x; u < 16 * 32; u += F.G) {
    const int bh = u >> 5, c = u & 31, b = bh >> 3, h = bh & 7;
    const bf16* base = F.PROJ + ((size_t)b * T + (size_t)c * 256) * NIN + h * RD;
    ret::unitA(base + C_RK, base + C_RV, F.UT + (size_t)u * 65536, (char*)F.lds);
  }
  __syncthreads();
}
__device__ __forceinline__ void ret_scan_phase(Frame& F) {
  const int gt = (F.vcu * NWAVES + F.wave) * 64 + F.lane, NT_ = F.G * NWAVES * 64;
  for (int e = gt; e < 16 * 16384; e += NT_) {
    const int bh = e >> 14, q = e & 16383, h = bh & 7;
    const float gC = __builtin_amdgcn_exp2f(c_log2g[h] * 256.f);
    const float* up = F.UT + (size_t)bh * 32 * 65536 + q * 4;
    bf16* sp = F.ST + (size_t)bh * 32 * 65536 + q * 4;
    f32x4 uv[31];
#pragma unroll
    for (int c = 0; c < 31; ++c) uv[c] = *(const GAS f32x4*)(up + (size_t)c * 65536);
    f32x4 s = (f32x4){0.f, 0.f, 0.f, 0.f};
#pragma unroll
    for (int c = 0; c < 32; ++c) {
      v2u w; w.x = pk2(s.x, s.y); w.y = pk2(s.z, s.w);
      *(GAS v2u*)(sp + (size_t)c * 65536) = w;
      if (c < 31) s = (s + uv[c]) * gC;
    }
  }
}
__device__ __forceinline__ void ret_passC_phase(Frame& F) {
  for (int u = blockIdx.x; u < 16 * 32; u += F.G) {
    const int bh = u >> 5, c = u & 31, b = bh >> 3, h = bh & 7;
    const size_t tok0 = (size_t)b * T + (size_t)c * 256;
    const bf16* base = F.PROJ + tok0 * NIN + h * RD;
    const bf16* ST = F.ST + (size_t)u * 65536;
    bf16* Mc = F.MIX + tok0 * D + 2048 + h * RD;
    ret::unitC(base + C_RQ, base + C_RK, base + C_RV, base + C_RG, ST, c != 0, F.g_ret + h * RD, Mc, 0, (char*)F.lds);
    ret::unitC(base + C_RQ, base + C_RK, base + C_RV, base + C_RG, ST, c != 0, F.g_ret + h * RD, Mc, 128, (char*)F.lds);
  }
  __syncthreads();
}

struct Args { const float* in[10]; float* out; unsigned char* ws; int ph_lo, ph_hi, li, pad; };
__global__ void __launch_bounds__(NWAVES * 64, 2) hymba_fwd(Args args) {
    extern __shared__ __attribute__((aligned(16))) unsigned char lds[];
    Frame F;
    F.lds = (LAS unsigned char*)lds;
    F.MISC = (volatile LAS unsigned*)(F.lds + MISC_OFF);
    F.tid = threadIdx.x; F.lane = F.tid & 63; F.wave = __builtin_amdgcn_readfirstlane(F.tid >> 6);
    F.G = gridDim.x; { const int bx = blockIdx.x; F.vcu = (F.G % 8 == 0) ? (bx % 8) * (F.G / 8) + bx / 8 : bx; }
    unsigned char* ws = args.ws;
    F.ctl = (gu32*)(ws + WS_CTL);
    F.x = args.in[0]; F.g_attn = args.in[1]; F.w_in = args.in[2]; F.g_sb = args.in[3]; F.g_ret = args.in[4]; F.w_out = args.in[5];
    F.g_mlp = args.in[6]; F.w_up = args.in[7]; F.w_down = args.in[8]; F.g_fin = args.in[9]; F.out = args.out;
    F.XN = (bf16*)(ws + WS_XN); F.WIN = (bf16*)(ws + WS_WIN); F.WOUT = (bf16*)(ws + WS_WOUT); F.PROJ = (bf16*)(ws + WS_PROJ); F.MIX = (bf16*)(ws + WS_MIX);
    F.WUP = (bf16*)args.out; F.HID = (bf16*)(ws + WS_HID); F.WDOWN = GROUP_TAIL ? (bf16*)(ws + WS_MIX) : (bf16*)args.out + (size_t)FF * D;
    F.SBO = (float*)(ws + WS_XN); F.ROPE = (float*)(ws + WS_ROPE); F.UT = (float*)(ws + WS_WIN); F.ST = (bf16*)(ws + WS_STATE); F.ATT = (bf16*)(ws + WS_ATT); F.MLP = (bf16*)(ws + WS_MLP); F.PART1 = (float*)(ws + WS_PART1); F.PARTSB = (float*)(ws + WS_PART1 + 4 * MiB); F.RSTDX = (float*)(ws + WS_PART1 + 5 * MiB);
    for (int u = F.tid; u < (LDS_BYTES - LDSCTL_OFF) / 4; u += NWAVES * 64) ((LAS unsigned*)(F.lds + LDSCTL_OFF))[u] = 0u;
    __syncthreads();
    XcdBarrier bar; bar.bar = (unsigned*)(F.ctl + CW_BAR); bar.x = 0; bar.st = nullptr;
    if (N_LAUNCHES != PER_PHASE) bar = xcd_barrier_post((unsigned*)(F.ctl + CW_BAR) + args.li * XCD_BAR_WORDS, F.MISC + 8);
#define GRID_BAR(seam) do { if (N_LAUNCHES == PER_PHASE) { if (F.tid == 0) __hip_atomic_store(F.ctl + CW_TMO, 0xBADBA0u | (unsigned)(seam), RLX_AGENT); } \
    else { xcd_barrier(bar); } } while (0)
    const int lo = args.ph_lo, hi = args.ph_hi;
#define IN(k) (lo <= (k) && (k) < hi)
#define BOTH(k) (IN(k) && IN((k) + 1))
    const int gw = F.vcu * NWAVES + F.wave, NGW = F.G * NWAVES;

    if (IN(0)) { p0_prologue(F); if (BOTH(0)) GRID_BAR(0); }
    if (IN(1)) {
        pg8::Gemm g{F.XN, F.WIN, M, NIN, D}; pg8::StaticOrder S; S.init(M, NIN, F.G, (int)blockIdx.x, WGM_P1);
        LAS float* tabx = (LAS float*)(F.lds + LDSCTL_OFF + 1024);
        { pg8::Unit u0, ui_; bool okpm = S.next(0, u0); for (int i = 1; S.next(i, ui_); ++i) okpm = okpm && (ui_.pm == u0.pm);
          if (F.tid < 256) tabx[F.tid] = okpm ? F.RSTDX[(size_t)u0.pm * 256 + F.tid] : __builtin_nanf("");
          __syncthreads(); }
        EpiProj E{F.PROJ, F.ROPE, tabx};
        pg8::gemm_phase<EpiProj, pg8::StaticOrder, GEMM_ALIGN, GEMM_SP2>(F.lds + RING_OFF, g, S, E);
        if (BOTH(1)) GRID_BAR(1);
    }
    if (IN(2)) { ret_passA_phase(F); if (BOTH(2)) GRID_BAR(2); }
    if (IN(3)) { ret_scan_phase(F); if (BOTH(3)) GRID_BAR(3); }
    if (IN(4)) { sb_fast_phase(F); ret_passC_phase(F);
        if (DEFER_OUT) drain_transposes(F, (unsigned*)(F.ctl + CW_QOUT), F.w_out, D, D, F.WOUT, F.g_sb, 2048);
        if (BOTH(4)) GRID_BAR(4); }
    if (IN(5)) { }
    if (IN(6)) {
        pg8::Gemm g{F.MIX, F.WOUT, M, D, D}; pg8::StaticOrder S; S.init(M, D, F.G, (int)blockIdx.x, WGM_P6);
        EpiX1 E{F.XN, F.ATT, F.PART1, D};
        LAS float* tabsb = (LAS float*)(F.lds + LDSCTL_OFF + 3072);
        { pg8::Unit u0, ui_; bool okpm = S.next(0, u0); for (int i = 1; S.next(i, ui_); ++i) okpm = okpm && (ui_.pm == u0.pm);
          const int row = F.tid >> 1, half = F.tid & 1;
          const GAS f32x4* pp = (const GAS f32x4*)(F.PARTSB + ((size_t)u0.pm * 256 + row) * 16 + half * 8);
          const f32x4 t0 = pp[0], t1 = pp[1]; float s = ((t0.x + t0.y) + (t0.z + t0.w)) + ((t1.x + t1.y) + (t1.z + t1.w));
          s += __shfl_xor(s, 1);
          if (half == 0) tabsb[row] = okpm ? 1.0f / sqrtf(s * (1.f / 2048.f) + EPS) : __builtin_nanf("");
          __syncthreads(); }
        ScaleRowsAt KH{2048 / 64, tabsb};
        pg8::gemm_phase<EpiX1, pg8::StaticOrder, GEMM_ALIGN, GEMM_SP2, ScaleRowsAt>(F.lds + RING_OFF, g, S, E, KH);
        if (DEFER_UP) drain_transposes(F, (unsigned*)(F.ctl + CW_QUP), F.w_up, D, FF, F.WUP, F.g_mlp);
        if (BOTH(6)) GRID_BAR(6);
    }
    if (IN(7)) { }
    if (IN(8)) {
        pg8::Gemm g{F.ATT, F.WUP, M, FF, D}; pg8::StaticOrder S; S.init(M, FF, F.G, (int)blockIdx.x, WGM_P8);
        LAS float* tab = (LAS float*)(F.lds + LDSCTL_OFF + 2048);
        { pg8::Unit u0, ui_; bool okpm = S.next(0, u0); for (int i = 1; S.next(i, ui_); ++i) okpm = okpm && (ui_.pm == u0.pm);
          const int row = F.tid >> 1, half = F.tid & 1;
          const GAS f32x4* pp = (const GAS f32x4*)(F.PART1 + ((size_t)u0.pm * 256 + row) * 64 + half * 32);
          float s = 0.f;
#pragma unroll
          for (int j = 0; j < 8; ++j) { const f32x4 t = pp[j]; s += (t.x + t.y) + (t.z + t.w); }
          s += __shfl_xor(s, 1);
          if (half == 0) tab[row] = okpm ? 1.0f / sqrtf(s * (1.f / 4096.f) + EPS) : __builtin_nanf("");
          __syncthreads(); }
        EpiRelu2S E{F.HID, FF, tab};
        pg8::gemm_phase<EpiRelu2S, pg8::StaticOrder, GEMM_ALIGN, GEMM_SP2>(F.lds + RING_OFF, g, S, E);
        if (DEFER_DOWN) drain_transposes(F, (unsigned*)(F.ctl + CW_QDN), F.w_down, FF, D, F.WDOWN, nullptr);
        if (BOTH(8)) GRID_BAR(8);
    }
    if (IN(9)) { }
    if (IN(10)) {
        pg8::Gemm g{F.HID, F.WDOWN, M, D, FF}; pg8::StaticOrder S; S.init(M, D, F.G, (int)blockIdx.x, WGM_P9);
        EpiBf16 E{F.MLP, D};
        pg8::gemm_phase<EpiBf16, pg8::StaticOrder, GEMM_ALIGN, GEMM_SP2>(F.lds + RING_OFF, g, S, E);
        if (BOTH(10)) {
            if (GROUP_TAIL && N_LAUNCHES != PER_PHASE && (F.G % 8) == 0) {
                group_arrive((unsigned*)(F.ctl + CW_GRP + 64 * (blockIdx.x % 8u)));
            } else GRID_BAR(10);
        }
    }
    if (IN(11)) {
        if (GROUP_TAIL && N_LAUNCHES != PER_PHASE && (F.G % 8) == 0 && IN(10)) {
            for (int k = 0; k < 8; ++k) {
                const int g = (int)((blockIdx.x + (unsigned)k) % 8u);
                group_wait((unsigned*)(F.ctl + CW_BAR), (unsigned*)(F.ctl + CW_GRP + 64 * g), (unsigned)(F.G / 8));
                unsigned* rq = (unsigned*)(F.ctl + CW_ROWQ + 64 * g);
                for (;;) {
                    unsigned base = 0u;
                    if (F.lane == 0) base = __hip_atomic_fetch_add(rq, 2u, __ATOMIC_RELAXED, __HIP_MEMORY_SCOPE_AGENT);
                    base = (unsigned)__builtin_amdgcn_readfirstlane((int)base);
                    if (base >= 2048u) break;
                    for (int r = (int)base; r < (int)base + 2; ++r) { const int m = 2048 * g + r;
                        rms_row_bb(F.ATT + (size_t)m * D, F.MLP + (size_t)m * D, F.g_fin, F.out + (size_t)m * D, F.lane); }
                }
            }
        } else
        for (int m = gw; m < M; m += NGW) rms_row_bb(F.ATT + (size_t)m * D, F.MLP + (size_t)m * D, F.g_fin, F.out + (size_t)m * D, F.lane);

    }
#undef IN
#undef BOTH
}

extern "C" void kernel_launch(void* const* d_in, const int* in_sizes, int n_in, void* d_out, int out_size, void* d_ws, size_t ws_size, hipStream_t stream) {
    static int grid = 0;
    if (grid == 0) {
        if (n_in != 10 || in_sizes[0] != M * D || out_size != M * D || ws_size < WS_END) { fprintf(stderr, "kernel_launch: shape/workspace mismatch (ws %zu, need %zu)\n", ws_size, (size_t)WS_END); grid = -1; return; }
        int dev = 0, cus = 0, per_cu = 0;
        if (hipGetDevice(&dev) != hipSuccess || hipDeviceGetAttribute(&cus, hipDeviceAttributeMultiprocessorCount, dev) != hipSuccess) { grid = -1; return; }
        if (hipFuncSetAttribute((const void*)hymba_fwd, hipFuncAttributeMaxDynamicSharedMemorySize, LDS_BYTES) != hipSuccess) { fprintf(stderr, "kernel_launch: hipFuncSetAttribute failed\n"); grid = -1; return; }
        if (hipOccupancyMaxActiveBlocksPerMultiprocessor(&per_cu, (const void*)hymba_fwd, NWAVES * 64, LDS_BYTES) != hipSuccess || per_cu < 1)
            fprintf(stderr, "kernel_launch: occupancy query reports %d workgroups per CU\n", per_cu);
        (void)hipGetLastError();
        grid = cus;
    }
    if (grid < 0) return;
    if (hipMemsetAsync((char*)d_ws + WS_CTL, 0, CTL_ZERO_BYTES, stream) != hipSuccess) return;
    Args a{};
    for (int i = 0; i < 10; ++i) a.in[i] = (const float*)d_in[i];
    a.out = (float*)d_out; a.ws = (unsigned char*)d_ws;
    if (N_LAUNCHES == 1) {
        a.ph_lo = 0; a.ph_hi = PER_PHASE; a.li = 0;
        hipLaunchKernelGGL(hymba_fwd, dim3(grid), dim3(NWAVES * 64), LDS_BYTES, stream, a);
    } else {
        for (int li = 0; li < PER_PHASE; ++li) {
            a.ph_lo = li; a.ph_hi = li + 1; a.li = 0;
            hipLaunchKernelGGL(hymba_fwd, dim3(grid), dim3(NWAVES * 64), LDS_BYTES, stream, a);
        }
    }
    const hipError_t le = hipPeekAtLastError();
    if (le != hipSuccess) fprintf(stderr, "kernel_launch: launch failed: %s\n", hipGetErrorName(le));
}
```
